# Optimizing an MI355X kernel written in HIP

```python
import math
import jax, jax.numpy as jnp
from jax import lax
import numpy as np

D_MODEL = 1024
BATCH = 8
SEQ = 4096
DEPTH = 4
DEC_BATCH = 4
DEC_SEQ = 8192
PAST_LEN = 128

HEAD_DIM = 64
MIX_WIDTH = D_MODEL
N_HEADS_A = MIX_WIDTH // (2 * HEAD_DIM)
N_KV_A = N_HEADS_A // 4
N_HEADS_B = MIX_WIDTH // (2 * HEAD_DIM)
N_KV_B = N_HEADS_B // 4
Q_A = N_HEADS_A * HEAD_DIM
KV_A = N_KV_A * HEAD_DIM
Q_B = N_HEADS_B * HEAD_DIM
KV_B = N_KV_B * HEAD_DIM
D_IN = Q_A + 2 * KV_A + Q_B + 2 * KV_B
WINDOW = 128
BLOCK = 128
NUM_BUCKETS = 32
MAX_DISTANCE = 128
GRID_W = 64
ROPE_THETA = 10000.0
D_FF = ((8 * D_MODEL + 3 * 256 - 1) // (3 * 256)) * 256
DEEPNORM_ALPHA = (2.0 * DEPTH) ** 0.25
DEEPNORM_BETA = (8.0 * DEPTH) ** -0.25
LN_EPS = 1e-5
RMS_EPS = 1e-6
NEG_INF = -1e30

kernel_name = "hymba_style_window_axial_encoder"


def layer_norm(x, g, b):
    xf = x.astype(jnp.float32)
    mu = jnp.mean(xf, axis=-1, keepdims=True)
    var = jnp.mean(jnp.square(xf - mu), axis=-1, keepdims=True)
    y = (xf - mu) * lax.rsqrt(var + LN_EPS) * g.astype(jnp.float32) + b.astype(jnp.float32)
    return y.astype(x.dtype)


def head_rms_norm(x, g):
    xf = x.astype(jnp.float32)
    y = xf * lax.rsqrt(jnp.mean(jnp.square(xf), axis=-1, keepdims=True) + RMS_EPS)
    return y * g.astype(jnp.float32)


def t5_bucket(rel):
    nb = NUM_BUCKETS // 2
    max_exact = nb // 2
    bucket = (rel > 0).astype(jnp.int32) * nb
    n = jnp.abs(rel)
    n_f = jnp.maximum(n, 1).astype(jnp.float32)
    large = max_exact + (jnp.log(n_f / max_exact) / math.log(MAX_DISTANCE / max_exact)
                         * (nb - max_exact)).astype(jnp.int32)
    large = jnp.minimum(large, nb - 1)
    return bucket + jnp.where(n < max_exact, n, large)


def windowed_sink_attention(q, k, v, sink, rel_table):
    B, S, Hq, D = q.shape
    Hkv = k.shape[2]
    G = Hq // Hkv
    nb = S // BLOCK
    scale = HEAD_DIM ** -0.5
    qb = q.reshape(B, nb, BLOCK, Hkv, G, D).transpose(1, 0, 2, 3, 4, 5)

    def windows(t):
        tp = jnp.pad(t, ((0, 0), (BLOCK, BLOCK), (0, 0), (0, 0)))
        tb = tp.reshape(B, nb + 2, BLOCK, Hkv, D)
        w = jnp.concatenate([tb[:, :-2], tb[:, 1:-1], tb[:, 2:]], axis=2)
        return w.transpose(1, 0, 2, 3, 4)

    kw = windows(k)
    vw = windows(v)
    i = jnp.arange(BLOCK)[:, None]
    j = jnp.arange(3 * BLOCK)[None, :]
    rel = (j - BLOCK) - i
    in_window = jnp.abs(rel) <= WINDOW
    bias = rel_table[t5_bucket(rel)]
    bias = bias.transpose(2, 0, 1).reshape(Hkv, G, BLOCK, 3 * BLOCK).astype(jnp.float32)
    kpos_base = jnp.arange(3 * BLOCK) - BLOCK
    sink_f = sink.astype(jnp.float32).reshape(Hkv, G, 1, 1)
    blk_ids = jnp.arange(nb)

    def one_block(args):
        qi, ki, vi, bidx = args
        kpos = bidx * BLOCK + kpos_base
        valid = in_window & ((kpos >= 0) & (kpos < S))[None, :]
        s = jnp.einsum('bqhgd,bkhd->bhgqk', qi, ki,
                       preferred_element_type=jnp.float32) * scale + bias
        s = jnp.where(valid, s, NEG_INF)
        m = jnp.maximum(jnp.max(s, axis=-1, keepdims=True), sink_f)
        p = jnp.exp(s - m)
        denom = jnp.sum(p, axis=-1, keepdims=True) + jnp.exp(sink_f - m)
        return jnp.einsum('bhgqk,bkhd->bqhgd', (p / denom).astype(vi.dtype), vi)

    out = lax.map(one_block, (qb, kw, vw, blk_ids))
    return out.transpose(1, 0, 2, 3, 4, 5).reshape(B, S, Hq * D)


def axial_rope_angles(S):
    rows = S // GRID_W
    row = jnp.repeat(jnp.arange(rows), GRID_W).astype(jnp.float32)
    col = jnp.tile(jnp.arange(GRID_W), rows).astype(jnp.float32)
    axis_dim = HEAD_DIM // 2
    inv = ROPE_THETA ** (-jnp.arange(0, axis_dim, 2, dtype=jnp.float32) / axis_dim)
    return jnp.concatenate([row[:, None] * inv, col[:, None] * inv], axis=-1)


def apply_rope(x, ang):
    B, S, H, D = x.shape
    xp = x.reshape(B, S, H, D // 2, 2)
    c = jnp.cos(ang)[None, :, None, :]
    s = jnp.sin(ang)[None, :, None, :]
    x0, x1 = xp[..., 0], xp[..., 1]
    out = jnp.stack([x0 * c - x1 * s, x0 * s + x1 * c], axis=-1)
    return out.reshape(B, S, H, D)


def axial_rope_attention(q, k, v, q_g, k_g):
    B, S, Hq, D = q.shape
    Hkv = k.shape[2]
    G = Hq // Hkv
    nb = S // BLOCK
    scale = HEAD_DIM ** -0.5
    ang = axial_rope_angles(S)
    q = apply_rope(head_rms_norm(q, q_g), ang).astype(v.dtype)
    k = apply_rope(head_rms_norm(k, k_g), ang).astype(v.dtype)
    qb = q.reshape(B, nb, BLOCK, Hkv, G, D).transpose(1, 0, 2, 3, 4, 5)

    def one_block(qi):
        s = jnp.einsum('bqhgd,bkhd->bhgqk', qi, k,
                       preferred_element_type=jnp.float32) * scale
        p = jax.nn.softmax(s, axis=-1)
        return jnp.einsum('bhgqk,bkhd->bqhgd', p.astype(v.dtype), v)

    out = lax.map(one_block, qb)
    return out.transpose(1, 0, 2, 3, 4, 5).reshape(B, S, Hq * D)


def encoder_layer(x, rel_table, w_in, w_out, sink, q_g, k_g, ln1_g, ln1_b,
                  w_gate, w_up, w_down, ln2_g, ln2_b):
    B, S, _ = x.shape
    proj = x @ w_in
    splits = [Q_A, Q_A + KV_A, Q_A + 2 * KV_A, Q_A + 2 * KV_A + Q_B, Q_A + 2 * KV_A + Q_B + KV_B]
    qa, ka, va, qb, kb, vb = jnp.split(proj, splits, axis=-1)
    oa = windowed_sink_attention(qa.reshape(B, S, N_HEADS_A, HEAD_DIM),
                                 ka.reshape(B, S, N_KV_A, HEAD_DIM),
                                 va.reshape(B, S, N_KV_A, HEAD_DIM), sink, rel_table)
    ob = axial_rope_attention(qb.reshape(B, S, N_HEADS_B, HEAD_DIM),
                              kb.reshape(B, S, N_KV_B, HEAD_DIM),
                              vb.reshape(B, S, N_KV_B, HEAD_DIM), q_g, k_g)
    mixed = jnp.concatenate([oa, ob], axis=-1) @ w_out
    x = layer_norm(DEEPNORM_ALPHA * x + mixed, ln1_g, ln1_b)
    h = jax.nn.silu(x @ w_gate) * (x @ w_up)
    x = layer_norm(DEEPNORM_ALPHA * x + h @ w_down, ln2_g, ln2_b)
    return x


def run_trunk(x, rel_table, w_in, w_out, attn_sink, q_norm_g, k_norm_g, ln1_g, ln1_b,
              w_gate, w_up, w_down, ln2_g, ln2_b):
    for l in range(DEPTH):
        x = encoder_layer(x, rel_table, w_in[l], w_out[l], attn_sink[l], q_norm_g[l], k_norm_g[l],
                          ln1_g[l], ln1_b[l], w_gate[l], w_up[l], w_down[l], ln2_g[l], ln2_b[l])
    return x


def setup_inputs(seed: int = 0) -> dict:
    key = jax.random.key(seed)
    ks = jax.random.split(key, 16)
    f32 = jnp.float32
    n = lambda k, shape: jax.random.normal(k, shape, dtype=f32)
    return {
        "x_prompt": n(ks[0], (BATCH, SEQ, D_MODEL)),
        "x_sample": n(ks[1], (DEC_BATCH, DEC_SEQ, D_MODEL)),
        "rel_bias_table": 0.5 * n(ks[2], (NUM_BUCKETS, N_HEADS_A)),
        "w_in": n(ks[3], (DEPTH, D_MODEL, D_IN)) * D_MODEL ** -0.5,
        "w_out": n(ks[4], (DEPTH, MIX_WIDTH, D_MODEL)) * MIX_WIDTH ** -0.5 * DEEPNORM_BETA,
        "attn_sink": 0.5 * n(ks[5], (DEPTH, N_HEADS_A)),
        "q_norm_g": 1.0 + 0.05 * n(ks[6], (DEPTH, HEAD_DIM)),
        "k_norm_g": 1.0 + 0.05 * n(ks[7], (DEPTH, HEAD_DIM)),
        "ln1_g": 1.0 + 0.05 * n(ks[8], (DEPTH, D_MODEL)),
        "ln1_b": 0.02 * n(ks[9], (DEPTH, D_MODEL)),
        "w_gate": n(ks[10], (DEPTH, D_MODEL, D_FF)) * D_MODEL ** -0.5,
        "w_up": n(ks[11], (DEPTH, D_MODEL, D_FF)) * D_MODEL ** -0.5,
        "w_down": n(ks[12], (DEPTH, D_FF, D_MODEL)) * D_FF ** -0.5 * DEEPNORM_BETA,
        "ln2_g": 1.0 + 0.05 * n(ks[13], (DEPTH, D_MODEL)),
        "ln2_b": 0.02 * n(ks[14], (DEPTH, D_MODEL)),
    }


def reference(x_prompt, x_sample, rel_bias_table, w_in, w_out, attn_sink, q_norm_g, k_norm_g,
              ln1_g, ln1_b, w_gate, w_up, w_down, ln2_g, ln2_b):
    y_prompt = run_trunk(x_prompt, rel_bias_table, w_in, w_out, attn_sink, q_norm_g, k_norm_g,
                         ln1_g, ln1_b, w_gate, w_up, w_down, ln2_g, ln2_b)
    y_sample = run_trunk(x_sample, rel_bias_table, w_in, w_out, attn_sink, q_norm_g, k_norm_g,
                         ln1_g, ln1_b, w_gate, w_up, w_down, ln2_g, ln2_b)
    return (y_prompt, y_sample)
```

```cpp
#include <hip/hip_runtime.h>
#include <hip/hip_cooperative_groups.h>
#include <cstdio>
#include <cstdint>
namespace cg = cooperative_groups;
#define ALPHA_DN 1.681792830507429f
#define LOG2E_F 1.4426950408889634f
#define QSCALE_F (0.125f * 1.4426950408889634f)
namespace pg8 {
#define PG8_LAS __attribute__((address_space(3)))
typedef unsigned short bf16_t;
typedef short bf16x8 __attribute__((ext_vector_type(8)));
typedef float f32x4 __attribute__((ext_vector_type(4)));
typedef unsigned u32x4 __attribute__((ext_vector_type(4)));
constexpr int BM = 256, BK = 64, HALF = 128, HTB = HALF * BK * 2  , STAGE_BYTES = 8 * HTB, NXCD = 8, WGM = 8;

__host__ __device__ __forceinline__ int lds_byte(int r, int c) { const int st = (r >> 4) * 2 + (c >> 5), rr = r & 15, cc = c & 31, ob = rr * 64 + cc * 2; return st * 1024 + (ob ^ (((ob >> 9) & 1) << 5)); }
__host__ __device__ __forceinline__ void stage_rc(int b, int& R, int& C) { const int st = b / 1024, sb = b % 1024, swz = sb ^ (((sb >> 9) & 1) << 5); R = (st >> 1) * 16 + swz / 64; C = (st & 1) * 32 + (swz % 64) / 2; }
__host__ __device__ __forceinline__ int perm32(int rho) { const int n = rho >> 4, i = rho & 15; return 8 * (i >> 2) + 4 * n + (i & 3); }

struct Unit { int pm, pn; };
struct Gemm { const bf16_t* A; const bf16_t* Bt; int M, N, K; };

struct StaticOrder {
    int nM, nN, nwg, G, c;
    __host__ __device__ void init(int M, int N, int G_, int c_) { nM = M / BM; nN = N / BM; nwg = nM * nN; G = G_; c = c_; }
    __host__ __device__ bool next(int i, Unit& u) const {
        const long L = (long)i * G + c; if (L >= nwg) return false;
        int wgid = (int)L; { const int q = nwg / NXCD, r = nwg % NXCD, xcd = wgid % NXCD, off = wgid / NXCD; wgid = (xcd < r ? xcd * (q + 1) : r * (q + 1) + (xcd - r) * q) + off; }
        const int nig = WGM * nN, gid = wgid / nig, fm = gid * WGM, gsz = (nM - fm) < WGM ? (nM - fm) : WGM;
        u.pm = fm + ((wgid % nig) % gsz); u.pn = (wgid % nig) / gsz; return true;
    }
    __device__ __forceinline__ void a_ready(const Unit&) const {}
    __device__ __forceinline__ void done(const Unit&) const {}
};

__device__ __forceinline__ unsigned cvt_pk_bf16(float lo, float hi) { unsigned r; asm volatile("v_cvt_pk_bf16_f32 %0, %1, %2" : "=v"(r) : "v"(lo), "v"(hi)); return r; }
struct EpiBf16 {
    static constexpr bool PERM = true, AFTER_DRAIN = false;
    bf16_t* O; int ldc;
    __device__ __forceinline__ void operator()(const f32x4 (&acc)[2][2][4][2], const Unit& u, int wr, int wc, int fr, int fq) const {
        const int row0 = u.pm * BM + wr * 64 + fr; const int col0 = u.pn * BM + wc * 32 + 8 * fq;
#pragma unroll
        for (int ai = 0; ai < 2; ++ai)
#pragma unroll
            for (int m = 0; m < 4; ++m) { bf16_t* rowp = O + (size_t)(row0 + ai * HALF + m * 16) * ldc + col0;
#pragma unroll
                for (int bj = 0; bj < 2; ++bj) { const f32x4 v0 = acc[ai][bj][m][0], v1 = acc[ai][bj][m][1];
                    u32x4 w; w.x = cvt_pk_bf16(v0[0], v0[1]); w.y = cvt_pk_bf16(v0[2], v0[3]); w.z = cvt_pk_bf16(v1[0], v1[1]); w.w = cvt_pk_bf16(v1[2], v1[3]);
                    *(u32x4*)(rowp + bj * HALF) = w; } }
    }
};
struct EpiVT {
    static constexpr bool PERM = true, AFTER_DRAIN = false;
    bf16_t* O;
    __device__ __forceinline__ void operator()(const f32x4 (&acc)[2][2][4][2], const Unit& u, int wr, int wc, int fr, int fq) const {
        const int row0 = wr * 64 + fr; const int col0 = u.pn * BM + wc * 32 + 8 * fq;
#pragma unroll
        for (int bj = 0; bj < 2; ++bj) { const int tok = col0 + bj * HALF; bf16_t* tp = O + (size_t)(tok >> 6) * (256 * 64) + (tok & 63);
#pragma unroll
            for (int ai = 0; ai < 2; ++ai)
#pragma unroll
                for (int m = 0; m < 4; ++m) { const f32x4 v0 = acc[ai][bj][m][0], v1 = acc[ai][bj][m][1];
                    u32x4 w; w.x = cvt_pk_bf16(v0[0], v0[1]); w.y = cvt_pk_bf16(v0[2], v0[3]); w.z = cvt_pk_bf16(v1[0], v1[1]); w.w = cvt_pk_bf16(v1[2], v1[3]);
                    *(u32x4*)(tp + (row0 + ai * HALF + m * 16) * 64) = w; } }
    }
};
struct EpiSwiGLU {
    static constexpr bool PERM = true, AFTER_DRAIN = false;
    bf16_t* O; int ldc;
    __device__ __forceinline__ void operator()(const f32x4 (&acc)[2][2][4][2], const Unit& u, int wr, int wc, int fr, int fq) const {
        const int row0 = u.pm * BM + wr * 64 + fr; const int col0 = u.pn * HALF + wc * 32 + 8 * fq;
#pragma unroll
        for (int ai = 0; ai < 2; ++ai)
#pragma unroll
            for (int m = 0; m < 4; ++m) { bf16_t* rowp = O + (size_t)(row0 + ai * HALF + m * 16) * ldc + col0;
                float h[8];
#pragma unroll
                for (int n = 0; n < 2; ++n)
#pragma unroll
                    for (int j = 0; j < 4; ++j) { const float g = acc[ai][0][m][n][j], up = acc[ai][1][m][n][j];
                        const float e = __builtin_amdgcn_exp2f(-g * LOG2E_F); h[n * 4 + j] = g * __builtin_amdgcn_rcpf(1.0f + e) * up; }
                u32x4 w; w.x = cvt_pk_bf16(h[0], h[1]); w.y = cvt_pk_bf16(h[2], h[3]); w.z = cvt_pk_bf16(h[4], h[5]); w.w = cvt_pk_bf16(h[6], h[7]);
                *(u32x4*)rowp = w; }
    }
};
struct EpiProj {
    static constexpr bool PERM = true, AFTER_DRAIN = false;
    bf16_t* O; const float* qg; const float* kg; const float* rope;
    __device__ __forceinline__ void operator()(const f32x4 (&acc)[2][2][4][2], const Unit& u, int wr, int wc, int fr, int fq) const {
        const int pn = u.pn; int ocol; const float* g = nullptr; float sc = 1.f;
        if (pn < 2) { ocol = (4 * pn + wc) * 64; sc = QSCALE_F; }
        else if (pn < 4) { ocol = 512 + (4 * (pn - 2) + wc) * 64; g = qg; sc = QSCALE_F; }
        else if (wc < 2) { ocol = 1024 + wc * 64; }
        else { ocol = 1152 + (wc - 2) * 64; g = kg; }
        const int row0 = u.pm * BM + wr * 64 + fr;
        if (g == nullptr) {
#pragma unroll
            for (int ai = 0; ai < 2; ++ai)
#pragma unroll
                for (int m = 0; m < 4; ++m) { bf16_t* rowp = O + (size_t)(row0 + ai * HALF + m * 16) * 1280 + ocol + 8 * fq;
#pragma unroll
                    for (int bj = 0; bj < 2; ++bj) { const f32x4 v0 = acc[ai][bj][m][0] * sc, v1 = acc[ai][bj][m][1] * sc;
                        u32x4 w; w.x = cvt_pk_bf16(v0[0], v0[1]); w.y = cvt_pk_bf16(v0[2], v0[3]); w.z = cvt_pk_bf16(v1[0], v1[1]); w.w = cvt_pk_bf16(v1[2], v1[3]);
                        *(u32x4*)(rowp + bj * 32) = w; } }
        } else {
            f32x4 gv[2][2];
#pragma unroll
            for (int bj = 0; bj < 2; ++bj)
#pragma unroll
                for (int n = 0; n < 2; ++n) gv[bj][n] = *(const f32x4*)(g + 32 * bj + 8 * fq + 4 * n) * sc;
#pragma unroll
            for (int ai = 0; ai < 2; ++ai)
#pragma unroll
                for (int m = 0; m < 4; ++m) { const int row = row0 + ai * HALF + m * 16; bf16_t* rowp = O + (size_t)row * 1280 + ocol + 8 * fq;
                    float ss = 0.f;
#pragma unroll
                    for (int bj = 0; bj < 2; ++bj)
#pragma unroll
                        for (int n = 0; n < 2; ++n) { const f32x4 v = acc[ai][bj][m][n]; ss += (v[0] * v[0] + v[1] * v[1]) + (v[2] * v[2] + v[3] * v[3]); }
                    ss += __shfl_xor(ss, 16); ss += __shfl_xor(ss, 32);
                    const float rinv = 1.0f / sqrtf(ss * (1.0f / 64.0f) + 1e-6f);
                    const int spos = row & (row < 32768 ? 4095 : 8191);
#pragma unroll
                    for (int bj = 0; bj < 2; ++bj) { const int pos = bj == 0 ? (spos >> 6) : (spos & 63); f32x4 o[2];
#pragma unroll
                        for (int n = 0; n < 2; ++n) { const f32x4 cs = *(const f32x4*)(rope + (pos * 16 + 4 * fq + 2 * n) * 2);
                            const f32x4 y = acc[ai][bj][m][n] * rinv * gv[bj][n];
                            o[n][0] = y[0] * cs[0] - y[1] * cs[1]; o[n][1] = y[0] * cs[1] + y[1] * cs[0];
                            o[n][2] = y[2] * cs[2] - y[3] * cs[3]; o[n][3] = y[2] * cs[3] + y[3] * cs[2]; }
                        u32x4 w; w.x = cvt_pk_bf16(o[0][0], o[0][1]); w.y = cvt_pk_bf16(o[0][2], o[0][3]); w.z = cvt_pk_bf16(o[1][0], o[1][1]); w.w = cvt_pk_bf16(o[1][2], o[1][3]);
                        *(u32x4*)(rowp + bj * 32) = w; } }
        }
    }
};
typedef _Float16 f16x8 __attribute__((ext_vector_type(8)));
template <class Epi, class Sched, bool ALIGN_EPI = false, bool SP2 = false, bool F16 = false>
__device__ __forceinline__ void gemm_phase(PG8_LAS unsigned char* lds, const Gemm g, const Sched& S, const Epi& E) {
    int tid_ = threadIdx.x; asm volatile("" : "+v"(tid_));
    const int tid = tid_, wid = __builtin_amdgcn_readfirstlane(tid >> 6), lane = tid & 63, wr = wid >> 2, wc = wid & 3, fr = lane & 15, fq = lane >> 4;
    const int K = g.K, nt = K / BK;
    unsigned voffA[2], voffB[2];
#pragma unroll
    for (int i = 0; i < 2; ++i) { int R, C; stage_rc(tid * 16 + i * 8192, R, C); const int Rb = Epi::PERM ? ((R & ~31) + perm32(R & 31)) : R;
        voffA[i] = (unsigned)(R * K + C) * 2u; voffB[i] = (unsigned)(Rb * K + C) * 2u; }
    const size_t kstep = (size_t)(BK * 2);
    const size_t hstep = (size_t)HALF * K * 2;
    const size_t tstep = 2 * hstep;
    const unsigned ldsw = (unsigned)wid * 1024u;
    const int aoff = lds_byte(wr * 64 + fr, fq * 8), boff = lds_byte(wc * 32 + fr, fq * 8);
#define PG8_SA(b, h) (((b) * 2 + (h)) * HTB)
#define PG8_SB(b, h) ((4 + (b) * 2 + (h)) * HTB)
#define PG8_STAGE(bufoff, gbase, voff) do { _Pragma("unroll") for (int _i = 0; _i < 2; ++_i) \
        __builtin_amdgcn_global_load_lds((const unsigned*)((const char*)(gbase) + (voff)[_i]), (PG8_LAS unsigned*)(lds + (bufoff) + ldsw + _i * 8192), 16, 0, 0); } while (0)
#define PG8_LDA(dst, b, h) do { _Pragma("unroll") for (int m = 0; m < 4; ++m) _Pragma("unroll") for (int k = 0; k < 2; ++k) dst[m][k] = *(const PG8_LAS bf16x8*)(lds + PG8_SA(b, h) + aoff + m * 2048 + k * 1024); } while (0)
#define PG8_LDB(dst, b, h) do { _Pragma("unroll") for (int n = 0; n < 2; ++n) _Pragma("unroll") for (int k = 0; k < 2; ++k) dst[n][k] = *(const PG8_LAS bf16x8*)(lds + PG8_SB(b, h) + boff + n * 2048 + k * 1024); } while (0)
#define PG8_MMA(ai, bj, At, Bt) do { __builtin_amdgcn_s_setprio(1); _Pragma("unroll") for (int m = 0; m < 4; ++m) _Pragma("unroll") for (int n = 0; n < 2; ++n) _Pragma("unroll") for (int k = 0; k < 2; ++k) \
        acc[ai][bj][m][n] = F16 ? __builtin_amdgcn_mfma_f32_16x16x32_f16(__builtin_bit_cast(f16x8, Bt[n][k]), __builtin_bit_cast(f16x8, At[m][k]), acc[ai][bj][m][n], 0, 0, 0) \
                                : __builtin_amdgcn_mfma_f32_16x16x32_bf16(Bt[n][k], At[m][k], acc[ai][bj][m][n], 0, 0, 0); __builtin_amdgcn_s_setprio(0); } while (0)
#define PG8_WAIT_V(n) asm volatile("s_waitcnt vmcnt(" #n ")" ::: "memory")
#define PG8_WAIT_L(n) asm volatile("s_waitcnt lgkmcnt(" #n ")" ::: "memory")
#define PG8_BAR __builtin_amdgcn_s_barrier()
#define PG8_SCHED __builtin_amdgcn_sched_barrier(0)
    Unit cur, nxt; int ui = 0;
    if (!S.next(0, cur)) return;
    f32x4 acc[2][2][4][2];
#pragma unroll
    for (int a = 0; a < 2; ++a)
#pragma unroll
        for (int b = 0; b < 2; ++b)
#pragma unroll
            for (int m = 0; m < 4; ++m)
#pragma unroll
                for (int n = 0; n < 2; ++n) acc[a][b][m][n] = (f32x4){0.f, 0.f, 0.f, 0.f};
    bf16x8 At[4][2], B0[2][2], B1[2][2];
    const char* cA = (const char*)g.A + (size_t)cur.pm * tstep; const char* cB = (const char*)g.Bt + (size_t)cur.pn * tstep;
    S.a_ready(cur);
    if constexpr (SP2) {
        PG8_STAGE(PG8_SB(0, 0), cB, voffB); PG8_STAGE(PG8_SB(0, 1), cB + hstep, voffB); PG8_STAGE(PG8_SA(0, 0), cA, voffA); PG8_STAGE(PG8_SA(0, 1), cA + hstep, voffA);
        if (wr == 1) PG8_BAR;
        PG8_WAIT_V(2); PG8_BAR;
        PG8_STAGE(PG8_SB(1, 0), cB + kstep, voffB); PG8_STAGE(PG8_SA(1, 0), cA + kstep, voffA); PG8_STAGE(PG8_SB(1, 1), cB + hstep + kstep, voffB);
        PG8_WAIT_V(6); PG8_BAR;
    } else {
        PG8_STAGE(PG8_SB(0, 0), cB, voffB); PG8_STAGE(PG8_SA(0, 0), cA, voffA); PG8_STAGE(PG8_SB(0, 1), cB + hstep, voffB); PG8_STAGE(PG8_SA(0, 1), cA + hstep, voffA);
        if (wr == 1) PG8_BAR;
        PG8_WAIT_V(4); PG8_BAR;
        PG8_STAGE(PG8_SB(1, 0), cB + kstep, voffB); PG8_STAGE(PG8_SA(1, 0), cA + kstep, voffA); PG8_STAGE(PG8_SB(1, 1), cB + hstep + kstep, voffB);
        PG8_WAIT_V(6); PG8_BAR;
    }
    for (;;) {
        const bool has_next = S.next(ui + 1, nxt);
        const char* nA = has_next ? (const char*)g.A + (size_t)nxt.pm * tstep : cA; const char* nB = has_next ? (const char*)g.Bt + (size_t)nxt.pn * tstep : cB;
        for (int t = 0; t < nt; t += 2) {
            const bool last = (t == nt - 2);
            const char* a1 = cA + (size_t)(t + 1) * kstep;
            const char* a2 = last ? nA : cA + (size_t)(t + 2) * kstep; const char* b2 = last ? nB : cB + (size_t)(t + 2) * kstep;
            const char* a3 = a2 + kstep; const char* b3 = b2 + kstep;
            if (last && has_next) S.a_ready(nxt);
            if constexpr (SP2) {
            PG8_LDB(B0, 0, 0); PG8_LDB(B1, 0, 1); PG8_SCHED; PG8_LDA(At, 0, 0); PG8_STAGE(PG8_SA(1, 1), a1 + hstep, voffA);
            PG8_WAIT_V(8); PG8_WAIT_L(0); PG8_BAR; PG8_MMA(0, 0, At, B0); PG8_MMA(0, 1, At, B1); PG8_BAR; PG8_SCHED;
            PG8_LDA(At, 0, 1); PG8_STAGE(PG8_SB(0, 0), b2, voffB); PG8_STAGE(PG8_SB(0, 1), b2 + hstep, voffB); PG8_STAGE(PG8_SA(0, 0), a2, voffA);
            PG8_WAIT_V(8); PG8_WAIT_L(0); PG8_BAR; PG8_MMA(1, 0, At, B0); PG8_MMA(1, 1, At, B1); PG8_BAR; PG8_SCHED;
            PG8_LDB(B0, 1, 0); PG8_LDB(B1, 1, 1); PG8_SCHED; PG8_LDA(At, 1, 0); PG8_STAGE(PG8_SA(0, 1), a2 + hstep, voffA);
            PG8_WAIT_V(8); PG8_WAIT_L(0); PG8_BAR; PG8_MMA(0, 0, At, B0); PG8_MMA(0, 1, At, B1); PG8_BAR; PG8_SCHED;
            PG8_LDA(At, 1, 1); PG8_STAGE(PG8_SB(1, 0), b3, voffB); PG8_STAGE(PG8_SB(1, 1), b3 + hstep, voffB); PG8_STAGE(PG8_SA(1, 0), a3, voffA);
            PG8_WAIT_V(8); PG8_WAIT_L(0); PG8_BAR; PG8_MMA(1, 0, At, B0); PG8_MMA(1, 1, At, B1); PG8_BAR; PG8_SCHED;
            } else {
            PG8_LDB(B0, 0, 0); PG8_SCHED; PG8_LDA(At, 0, 0); PG8_STAGE(PG8_SA(1, 1), a1 + hstep, voffA);
            PG8_WAIT_L(8); PG8_BAR; PG8_WAIT_L(0); PG8_MMA(0, 0, At, B0); PG8_BAR; PG8_SCHED;
            PG8_LDB(B1, 0, 1); PG8_STAGE(PG8_SB(0, 0), b2, voffB);
            PG8_BAR; PG8_WAIT_L(0); PG8_MMA(0, 1, At, B1); PG8_BAR;
            PG8_LDA(At, 0, 1); PG8_STAGE(PG8_SA(0, 0), a2, voffA);
            PG8_BAR; PG8_WAIT_L(0); PG8_MMA(1, 0, At, B0); PG8_BAR; PG8_SCHED;
            PG8_STAGE(PG8_SB(0, 1), b2 + hstep, voffB);
            PG8_WAIT_V(6); PG8_BAR; PG8_MMA(1, 1, At, B1); PG8_BAR;
            PG8_LDB(B0, 1, 0); PG8_SCHED; PG8_LDA(At, 1, 0); PG8_STAGE(PG8_SA(0, 1), a2 + hstep, voffA);
            PG8_WAIT_L(8); PG8_BAR; PG8_WAIT_L(0); PG8_MMA(0, 0, At, B0); PG8_BAR; PG8_SCHED;
            PG8_LDB(B1, 1, 1); PG8_STAGE(PG8_SB(1, 0), b3, voffB);
            PG8_BAR; PG8_WAIT_L(0); PG8_MMA(0, 1, At, B1); PG8_BAR;
            PG8_LDA(At, 1, 1); PG8_STAGE(PG8_SA(1, 0), a3, voffA);
            PG8_BAR; PG8_WAIT_L(0); PG8_MMA(1, 0, At, B0); PG8_BAR; PG8_SCHED;
            PG8_STAGE(PG8_SB(1, 1), b3 + hstep, voffB);
            PG8_WAIT_V(6); PG8_BAR; PG8_MMA(1, 1, At, B1); PG8_BAR;
            }
        }
        if constexpr (ALIGN_EPI) { if (wr == 0) PG8_BAR; }
        if constexpr (!Epi::AFTER_DRAIN) { E(acc, cur, wr, wc, fr, fq); S.done(cur); }
        if (!has_next) break;
#pragma unroll
        for (int a = 0; a < 2; ++a)
#pragma unroll
            for (int b = 0; b < 2; ++b)
#pragma unroll
                for (int m = 0; m < 4; ++m)
#pragma unroll
                    for (int n = 0; n < 2; ++n) acc[a][b][m][n] = (f32x4){0.f, 0.f, 0.f, 0.f};
        cur = nxt; cA = nA; cB = nB; ++ui;
        if constexpr (ALIGN_EPI) { if (wr == 1) PG8_BAR; }
    }
    PG8_WAIT_V(0);
    if constexpr (!ALIGN_EPI) { if (wr == 0) PG8_BAR; }
    PG8_BAR;
    if constexpr (Epi::AFTER_DRAIN) { E.fused(acc, cur, wr, wc, fr, fq, lds, wid, lane); S.done(cur); }
#undef PG8_SA
#undef PG8_SB
#undef PG8_STAGE
#undef PG8_LDA
#undef PG8_LDB
#undef PG8_MMA
#undef PG8_WAIT_V
#undef PG8_WAIT_L
#undef PG8_BAR
#undef PG8_SCHED
}
}
namespace att {
#define LAS __attribute__((address_space(3)))
typedef unsigned short bf16_t;
typedef short bf16x8 __attribute__((ext_vector_type(8)));
typedef float f32x16 __attribute__((ext_vector_type(16)));
typedef float f32x4 __attribute__((ext_vector_type(4)));
typedef unsigned u32x4 __attribute__((ext_vector_type(4)));
typedef unsigned u32x2 __attribute__((ext_vector_type(2)));
typedef float f32x2_t __attribute__((ext_vector_type(2))); typedef __bf16 bf16x2_t __attribute__((ext_vector_type(2)));
__device__ __forceinline__ unsigned cvtpk(float lo, float hi) { f32x2_t v = {lo, hi}; bf16x2_t b = __builtin_convertvector(v, bf16x2_t); return __builtin_bit_cast(unsigned, b); }
constexpr int KP = 144;
constexpr int TB = 64 * KP;
constexpr int OFF_K = 0, OFF_V = 2 * TB, OFF_LUT = 4 * TB, ATT_LDS = 4 * TB + 4 * 1040;
constexpr int PITCH_P = 1280, PITCH_VT = 65536, PITCH_O = 1024;

template <int WIN>
__device__ __forceinline__ void attn_unit(LAS unsigned char* lds, const bf16_t* __restrict__ PROJ, const bf16_t* __restrict__ VT, bf16_t* __restrict__ AO,
                                          int rowbase, int S, int hq, int q0, const float* __restrict__ lut_g, float sink2  ) {
    int tid_ = threadIdx.x; asm volatile("" : "+v"(tid_));
    const int tid = tid_, lane = tid & 63, r32 = lane & 31, hi = lane >> 5; const int wid = __builtin_amdgcn_readfirstlane(tid >> 6);
    const int kvh = hq >> 2;
    const int qcol = WIN ? hq * 64 : 512 + hq * 64;
    const int kcol = WIN ? 1024 + kvh * 64 : 1152 + kvh * 64;
    const int vrow0 = WIN ? kvh * 64 : 128 + kvh * 64;
    const int ocol = WIN ? hq * 64 : 512 + hq * 64;
    int kt0 = 0, kt1 = S >> 6;
    if (WIN) { const int lo = q0 - 128, hi_ = q0 + 256 + 128; kt0 = (lo < 0 ? 0 : lo) >> 6; kt1 = (hi_ > S ? S : hi_) >> 6; }
    const int krow = tid >> 3, kch = tid & 7;
    const bf16_t* ksrc = PROJ + (size_t)(rowbase + krow) * PITCH_P + kcol + kch * 8;
    const bf16_t* vsrc = VT + ((size_t)(rowbase >> 6) * 256 + vrow0 + krow) * 64 + kch * 8;
    const int kdst = OFF_K + krow * KP + kch * 16;
    const int vdst = OFF_V + krow * KP + (kch >> 1) * 32 + (kch & 1) * 8;
    LAS float* lut = (LAS float*)(lds + OFF_LUT);
    if (WIN) { if (tid < 257) lut[tid] = lut_g[tid]; }
    const int qw = q0 + wid * 32;
    const bf16_t* qp = PROJ + (size_t)(rowbase + qw + r32) * PITCH_P + qcol + hi * 8;
    bf16x8 qf[4];
#pragma unroll
    for (int ds = 0; ds < 4; ++ds) qf[ds] = *(const bf16x8*)(qp + ds * 16);
    u32x4 kreg = *(const u32x4*)(ksrc + (size_t)kt0 * 64 * PITCH_P);
    u32x4 vreg = *(const u32x4*)(vsrc + (size_t)kt0 * 16384);
    *(LAS u32x4*)(lds + kdst) = kreg;
    *(LAS u32x2*)(lds + vdst) = (u32x2){vreg.x, vreg.y}; *(LAS u32x2*)(lds + vdst + 16) = (u32x2){vreg.z, vreg.w};
    if (kt0 + 1 < kt1) { kreg = *(const u32x4*)(ksrc + (size_t)(kt0 + 1) * 64 * PITCH_P); vreg = *(const u32x4*)(vsrc + (size_t)(kt0 + 1) * 16384); }
    float m = WIN ? sink2 : 0.f, l = WIN ? 0.5f : 0.f;
    f32x16 negb; { const float nb_ = WIN ? 0.f : -sink2;
#pragma unroll
      for (int r = 0; r < 16; ++r) negb[r] = nb_; }
    f32x16 o0 = {}, o1 = {};
    __syncthreads();
    for (int t = kt0; t < kt1; ++t) {
        const int cur = (t - kt0) & 1;
        if (t + 1 < kt1) {
            const int nb = (cur ^ 1) * TB;
            *(LAS u32x4*)(lds + nb + kdst) = kreg;
            *(LAS u32x2*)(lds + nb + vdst) = (u32x2){vreg.x, vreg.y}; *(LAS u32x2*)(lds + nb + vdst + 16) = (u32x2){vreg.z, vreg.w};
            if (t + 2 < kt1) { kreg = *(const u32x4*)(ksrc + (size_t)(t + 2) * 64 * PITCH_P); vreg = *(const u32x4*)(vsrc + (size_t)(t + 2) * 16384); }
        }
        const int k0 = t * 64;
        bool active = true;
        if (WIN) active = (k0 + 63 >= qw - 128) && (k0 <= qw + 31 + 128);
        if (active) {
            const LAS unsigned char* kb = lds + OFF_K + cur * TB + r32 * KP + hi * 16;
            f32x16 sA = negb, sB = negb;
#pragma unroll
            for (int ds = 0; ds < 4; ++ds) {
                const bf16x8 ka = *(const LAS bf16x8*)(kb + ds * 32);
                const bf16x8 kb2 = *(const LAS bf16x8*)(kb + 32 * KP + ds * 32);
                sA = __builtin_amdgcn_mfma_f32_32x32x16_bf16(ka, qf[ds], sA, 0, 0, 0);
                sB = __builtin_amdgcn_mfma_f32_32x32x16_bf16(kb2, qf[ds], sB, 0, 0, 0);
            }
            if (WIN) {
                const int qpos = qw + r32;
#pragma unroll
                for (int r = 0; r < 16; ++r) {
                    const int key = k0 + (r & 3) + 8 * (r >> 2) + 4 * hi;
                    int relA = key - qpos + 128, relB = relA + 32;
                    const bool vA = (relA >= 0) && (relA <= 256), vB = (relB >= 0) && (relB <= 256);
                    relA = relA < 0 ? 0 : (relA > 256 ? 256 : relA); relB = relB < 0 ? 0 : (relB > 256 ? 256 : relB);
                    sA[r] = vA ? sA[r] + lut[relA] : -1e30f; sB[r] = vB ? sB[r] + lut[relB] : -1e30f;
                }
            }
            if (WIN) {
            float mx = fmaxf(sA[0], sB[0]);
#pragma unroll
            for (int r = 1; r < 16; ++r) mx = fmaxf(mx, fmaxf(sA[r], sB[r]));
            mx = fmaxf(mx, __shfl_xor(mx, 32));
            const float mn = fmaxf(m, mx);
            const float alpha = __builtin_amdgcn_exp2f(m - mn);
            m = mn;
            float ps = 0.f;
#pragma unroll
            for (int r = 0; r < 16; ++r) { sA[r] = __builtin_amdgcn_exp2f(sA[r] - mn); sB[r] = __builtin_amdgcn_exp2f(sB[r] - mn); ps += sA[r] + sB[r]; }
            l = l * alpha + ps;
#pragma unroll
            for (int r = 0; r < 16; ++r) { o0[r] *= alpha; o1[r] *= alpha; }
            } else {
                float ps = 0.f;
#pragma unroll
                for (int r = 0; r < 16; ++r) { sA[r] = __builtin_amdgcn_exp2f(sA[r]); sB[r] = __builtin_amdgcn_exp2f(sB[r]); ps += sA[r] + sB[r]; }
                l += ps;
            }
            bf16x8 pk[4];
            { u32x4 w;
              w.x = cvtpk(sA[0], sA[1]); w.y = cvtpk(sA[2], sA[3]); w.z = cvtpk(sA[4], sA[5]); w.w = cvtpk(sA[6], sA[7]); pk[0] = __builtin_bit_cast(bf16x8, w);
              w.x = cvtpk(sA[8], sA[9]); w.y = cvtpk(sA[10], sA[11]); w.z = cvtpk(sA[12], sA[13]); w.w = cvtpk(sA[14], sA[15]); pk[1] = __builtin_bit_cast(bf16x8, w);
              w.x = cvtpk(sB[0], sB[1]); w.y = cvtpk(sB[2], sB[3]); w.z = cvtpk(sB[4], sB[5]); w.w = cvtpk(sB[6], sB[7]); pk[2] = __builtin_bit_cast(bf16x8, w);
              w.x = cvtpk(sB[8], sB[9]); w.y = cvtpk(sB[10], sB[11]); w.z = cvtpk(sB[12], sB[13]); w.w = cvtpk(sB[14], sB[15]); pk[3] = __builtin_bit_cast(bf16x8, w); }
            const LAS unsigned char* vb = lds + OFF_V + cur * TB + r32 * KP + hi * 16;
#pragma unroll
            for (int s = 0; s < 4; ++s) {
                const bf16x8 va = *(const LAS bf16x8*)(vb + s * 32);
                const bf16x8 vb2 = *(const LAS bf16x8*)(vb + 32 * KP + s * 32);
                o0 = __builtin_amdgcn_mfma_f32_32x32x16_bf16(va, pk[s], o0, 0, 0, 0);
                o1 = __builtin_amdgcn_mfma_f32_32x32x16_bf16(vb2, pk[s], o1, 0, 0, 0);
            }
        }
        asm volatile("s_waitcnt lgkmcnt(0)\n\ts_barrier" ::: "memory");
    }
    const float lt = l + __shfl_xor(l, 32);
    const float inv = 1.0f / lt;
    bf16_t* op = AO + (size_t)(rowbase + qw + r32) * PITCH_O + ocol + 4 * hi;
#pragma unroll
    for (int g4 = 0; g4 < 4; ++g4) {
        u32x2 w0, w1;
        w0.x = cvtpk(o0[4 * g4] * inv, o0[4 * g4 + 1] * inv); w0.y = cvtpk(o0[4 * g4 + 2] * inv, o0[4 * g4 + 3] * inv);
        w1.x = cvtpk(o1[4 * g4] * inv, o1[4 * g4 + 1] * inv); w1.y = cvtpk(o1[4 * g4 + 2] * inv, o1[4 * g4 + 3] * inv);
        *(u32x2*)(op + 8 * g4) = w0; *(u32x2*)(op + 32 + 8 * g4) = w1;
    }
}

#define ATT_BAR() asm volatile("s_waitcnt lgkmcnt(0)\n\ts_barrier" ::: "memory")
__device__ __forceinline__ void attn_global(LAS unsigned char* lds, const bf16_t* __restrict__ PROJ, const bf16_t* __restrict__ VT, bf16_t* __restrict__ AO,
                                            int rowbase, int S, int hq, int q0, float bound2) {
    int tid_ = threadIdx.x; asm volatile("" : "+v"(tid_));
    const int tid = tid_, lane = tid & 63, r32 = lane & 31, hi = lane >> 5; const int wid = __builtin_amdgcn_readfirstlane(tid >> 6);
    const int kvh = hq >> 2, qcol = 512 + hq * 64, kcol = 1152 + kvh * 64, vrow0 = 128 + kvh * 64, ocol = 512 + hq * 64;
    const int T = S >> 6;
    const int krow = tid >> 3, kch = tid & 7;
    const bf16_t* ksrc = PROJ + (size_t)(rowbase + krow) * PITCH_P + kcol + kch * 8;
    const bf16_t* vsrc = VT + ((size_t)(rowbase >> 6) * 256 + vrow0 + krow) * 64 + kch * 8;
    constexpr int RK = 0, RV = 4 * TB;
    const int kdst = RK + krow * KP + kch * 16;
    const int vdst = RV + krow * KP + (kch >> 1) * 32 + (kch & 1) * 8;
    const int qw = q0 + wid * 32;
    const bf16_t* qp = PROJ + (size_t)(rowbase + qw + r32) * PITCH_P + qcol + hi * 8;
    bf16x8 qf[4];
#pragma unroll
    for (int ds = 0; ds < 4; ++ds) qf[ds] = *(const bf16x8*)(qp + ds * 16);
#define LDK(t) (*(const u32x4*)(ksrc + (size_t)(t) * 64 * PITCH_P))
#define LDV(t) (*(const u32x4*)(vsrc + (size_t)(t) * 16384))
#define STK(slot, reg) (*(LAS u32x4*)(lds + (slot) * TB + kdst) = (reg))
#define STV(slot, reg) do { *(LAS u32x2*)(lds + (slot) * TB + vdst) = (u32x2){(reg).x, (reg).y}; *(LAS u32x2*)(lds + (slot) * TB + vdst + 16) = (u32x2){(reg).z, (reg).w}; } while (0)
    u32x4 kra, krb, vra, vrb;
    kra = LDK(0); krb = LDK(1); vra = LDV(0); vrb = LDV(1);
    STK(0, kra); STK(1, krb); STV(0, vra); STV(1, vrb);
    kra = LDK(2); STK(2, kra);
    kra = LDK(3); krb = LDK(4); vra = LDV(2); vrb = LDV(3);
    const f32x16 zero16 = {};
    f32x16 lacc = {};
    const bf16x8 ones8 = {0x3F80, 0x3F80, 0x3F80, 0x3F80, 0x3F80, 0x3F80, 0x3F80, 0x3F80};
    f32x16 o0 = {}, o1 = {}, sA, sB, nA, nB;
    const LAS unsigned char* kfb = lds + RK + r32 * KP + hi * 16;
    const LAS unsigned char* vfb = lds + RV + r32 * KP + hi * 16;
#define QK_TILE(SA, SB, slot) do { _Pragma("unroll") for (int ds = 0; ds < 4; ++ds) { \
        const bf16x8 ka_ = *(const LAS bf16x8*)(kfb + (slot) * TB + ds * 32), kb_ = *(const LAS bf16x8*)(kfb + (slot) * TB + 32 * KP + ds * 32); \
        SA = __builtin_amdgcn_mfma_f32_32x32x16_bf16(ka_, qf[ds], ds == 0 ? zero16 : SA, 0, 0, 0); \
        SB = __builtin_amdgcn_mfma_f32_32x32x16_bf16(kb_, qf[ds], ds == 0 ? zero16 : SB, 0, 0, 0); } } while (0)
    ATT_BAR();
    QK_TILE(sA, sB, 0);
    ATT_BAR();
#define ATT_HALF(SA, SB, NA, NB, ks, vs, DOQK) do { \
        if (DOQK) QK_TILE(NA, NB, ks); \
        _Pragma("unroll") for (int r = 0; r < 16; ++r) { SA[r] = __builtin_amdgcn_exp2f(SA[r]); SB[r] = __builtin_amdgcn_exp2f(SB[r]); } \
        bf16x8 pk_[4]; { u32x4 w_; \
          w_.x = cvtpk(SA[0], SA[1]); w_.y = cvtpk(SA[2], SA[3]); w_.z = cvtpk(SA[4], SA[5]); w_.w = cvtpk(SA[6], SA[7]); pk_[0] = __builtin_bit_cast(bf16x8, w_); \
          w_.x = cvtpk(SA[8], SA[9]); w_.y = cvtpk(SA[10], SA[11]); w_.z = cvtpk(SA[12], SA[13]); w_.w = cvtpk(SA[14], SA[15]); pk_[1] = __builtin_bit_cast(bf16x8, w_); \
          w_.x = cvtpk(SB[0], SB[1]); w_.y = cvtpk(SB[2], SB[3]); w_.z = cvtpk(SB[4], SB[5]); w_.w = cvtpk(SB[6], SB[7]); pk_[2] = __builtin_bit_cast(bf16x8, w_); \
          w_.x = cvtpk(SB[8], SB[9]); w_.y = cvtpk(SB[10], SB[11]); w_.z = cvtpk(SB[12], SB[13]); w_.w = cvtpk(SB[14], SB[15]); pk_[3] = __builtin_bit_cast(bf16x8, w_); } \
        _Pragma("unroll") for (int s = 0; s < 4; ++s) { \
            const bf16x8 va_ = *(const LAS bf16x8*)(vfb + (vs) * TB + s * 32), vb_ = *(const LAS bf16x8*)(vfb + (vs) * TB + 32 * KP + s * 32); \
            o0 = __builtin_amdgcn_mfma_f32_32x32x16_bf16(va_, pk_[s], o0, 0, 0, 0); \
            o1 = __builtin_amdgcn_mfma_f32_32x32x16_bf16(vb_, pk_[s], o1, 0, 0, 0); \
            lacc = __builtin_amdgcn_mfma_f32_32x32x16_bf16(ones8, pk_[s], lacc, 0, 0, 0); } } while (0)
#define ATT_DSTEP(t, p, FULL) do { \
        if (FULL || (t) + 3 < T) STK(((p) + 3) & 3, kra); \
        if (FULL || (t) + 4 < T) STK((p), krb); \
        if (FULL || (t) + 2 < T) STV(((p) + 2) & 3, vra); \
        if (FULL || (t) + 3 < T) STV(((p) + 3) & 3, vrb); \
        if (FULL || (t) + 5 < T) kra = LDK((t) + 5); \
        if (FULL || (t) + 6 < T) krb = LDK((t) + 6); \
        if (FULL || (t) + 4 < T) vra = LDV((t) + 4); \
        if (FULL || (t) + 5 < T) vrb = LDV((t) + 5); \
        ATT_HALF(sA, sB, nA, nB, ((p) + 1) & 3, (p), (FULL || (t) + 1 < T)); \
        ATT_HALF(nA, nB, sA, sB, ((p) + 2) & 3, ((p) + 1) & 3, (FULL || (t) + 2 < T)); \
        ATT_BAR(); } while (0)
    int t = 0;
#pragma unroll 1
    for (; t + 10 < T; t += 4) { ATT_DSTEP(t, 0, true); ATT_DSTEP(t + 2, 2, true); }
#pragma unroll 1
    for (; t < T; t += 4) { ATT_DSTEP(t, 0, false); ATT_DSTEP(t + 2, 2, false); }
#undef ATT_DSTEP
#undef ATT_HALF
#undef QK_TILE
#undef LDK
#undef LDV
#undef STK
#undef STV
    const float inv = 1.0f / lacc[0];
    bf16_t* op = AO + (size_t)(rowbase + qw + r32) * PITCH_O + ocol + 4 * hi;
#pragma unroll
    for (int g4 = 0; g4 < 4; ++g4) {
        u32x2 w0, w1;
        w0.x = cvtpk(o0[4 * g4] * inv, o0[4 * g4 + 1] * inv); w0.y = cvtpk(o0[4 * g4 + 2] * inv, o0[4 * g4 + 3] * inv);
        w1.x = cvtpk(o1[4 * g4] * inv, o1[4 * g4 + 1] * inv); w1.y = cvtpk(o1[4 * g4 + 2] * inv, o1[4 * g4 + 3] * inv);
        *(u32x2*)(op + 8 * g4) = w0; *(u32x2*)(op + 32 + 8 * g4) = w1;
    }
}

__device__ __forceinline__ void attn_win(LAS unsigned char* lds, const bf16_t* __restrict__ PROJ, const bf16_t* __restrict__ VT, bf16_t* __restrict__ AO,
                                         int rowbase, int S, int kvh, int q0, const float* __restrict__ lut_g  , const float* __restrict__ sinkp  ) {
    int tid_ = threadIdx.x; asm volatile("" : "+v"(tid_));
    const int tid = tid_, lane = tid & 63, r32 = lane & 31, hi = lane >> 5; const int wid = __builtin_amdgcn_readfirstlane(tid >> 6);
    const int hq = kvh * 4 + (wid >> 1);
    const int qcol = hq * 64, kcol = 1024 + kvh * 64, vrow0 = kvh * 64, ocol = hq * 64;
    const int lo = q0 - 128, hi_ = q0 + 64 + 128;
    const int kt0 = (lo < 0 ? 0 : lo) >> 6, kt1 = (hi_ > S ? S : hi_) >> 6;
    const int krow = tid >> 3, kch = tid & 7;
    const bf16_t* ksrc = PROJ + (size_t)(rowbase + krow) * PITCH_P + kcol + kch * 8;
    const bf16_t* vsrc = VT + ((size_t)(rowbase >> 6) * 256 + vrow0 + krow) * 64 + kch * 8;
    const int kdst = OFF_K + krow * KP + kch * 16;
    const int vdst = OFF_V + krow * KP + (kch >> 1) * 32 + (kch & 1) * 8;
    LAS float* lut4 = (LAS float*)(lds + OFF_LUT);
    for (int i = tid; i < 4 * 260; i += 512) lut4[i] = lut_g[kvh * 4 * 260 + i];
    const LAS float* lut = lut4 + (wid >> 1) * 260;
    const float sink2 = sinkp[hq] * LOG2E_F;
    const int qw = q0 + (wid & 1) * 32;
    const bf16_t* qp = PROJ + (size_t)(rowbase + qw + r32) * PITCH_P + qcol + hi * 8;
    bf16x8 qf[4];
#pragma unroll
    for (int ds = 0; ds < 4; ++ds) qf[ds] = *(const bf16x8*)(qp + ds * 16);
    u32x4 kreg = *(const u32x4*)(ksrc + (size_t)kt0 * 64 * PITCH_P);
    u32x4 vreg = *(const u32x4*)(vsrc + (size_t)kt0 * 16384);
    *(LAS u32x4*)(lds + kdst) = kreg;
    *(LAS u32x2*)(lds + vdst) = (u32x2){vreg.x, vreg.y}; *(LAS u32x2*)(lds + vdst + 16) = (u32x2){vreg.z, vreg.w};
    if (kt0 + 1 < kt1) { kreg = *(const u32x4*)(ksrc + (size_t)(kt0 + 1) * 64 * PITCH_P); vreg = *(const u32x4*)(vsrc + (size_t)(kt0 + 1) * 16384); }
    float m = sink2, l = 0.5f;
    f32x16 o0 = {}, o1 = {};
    asm volatile("s_waitcnt lgkmcnt(0)\n\ts_barrier" ::: "memory");
    for (int t = kt0; t < kt1; ++t) {
        const int cur = (t - kt0) & 1;
        if (t + 1 < kt1) {
            const int nb = (cur ^ 1) * TB;
            *(LAS u32x4*)(lds + nb + kdst) = kreg;
            *(LAS u32x2*)(lds + nb + vdst) = (u32x2){vreg.x, vreg.y}; *(LAS u32x2*)(lds + nb + vdst + 16) = (u32x2){vreg.z, vreg.w};
            if (t + 2 < kt1) { kreg = *(const u32x4*)(ksrc + (size_t)(t + 2) * 64 * PITCH_P); vreg = *(const u32x4*)(vsrc + (size_t)(t + 2) * 16384); }
        }
        const int k0 = t * 64;
        if ((k0 + 63 >= qw - 128) && (k0 <= qw + 31 + 128)) {
            const LAS unsigned char* kb = lds + OFF_K + cur * TB + r32 * KP + hi * 16;
            f32x16 sA = {}, sB = {};
#pragma unroll
            for (int ds = 0; ds < 4; ++ds) {
                const bf16x8 ka = *(const LAS bf16x8*)(kb + ds * 32);
                const bf16x8 kb2 = *(const LAS bf16x8*)(kb + 32 * KP + ds * 32);
                sA = __builtin_amdgcn_mfma_f32_32x32x16_bf16(ka, qf[ds], sA, 0, 0, 0);
                sB = __builtin_amdgcn_mfma_f32_32x32x16_bf16(kb2, qf[ds], sB, 0, 0, 0);
            }
            const int qpos = qw + r32;
#pragma unroll
            for (int r = 0; r < 16; ++r) {
                const int key = k0 + (r & 3) + 8 * (r >> 2) + 4 * hi;
                int relA = key - qpos + 128, relB = relA + 32;
                const bool vA = (relA >= 0) && (relA <= 256), vB = (relB >= 0) && (relB <= 256);
                relA = relA < 0 ? 0 : (relA > 256 ? 256 : relA); relB = relB < 0 ? 0 : (relB > 256 ? 256 : relB);
                sA[r] = vA ? sA[r] + lut[relA] : -1e30f; sB[r] = vB ? sB[r] + lut[relB] : -1e30f;
            }
            float mx = fmaxf(sA[0], sB[0]);
#pragma unroll
            for (int r = 1; r < 16; ++r) mx = fmaxf(mx, fmaxf(sA[r], sB[r]));
            mx = fmaxf(mx, __shfl_xor(mx, 32));
            const float mn = fmaxf(m, mx);
            const float alpha = __builtin_amdgcn_exp2f(m - mn);
            m = mn;
            float ps = 0.f;
#pragma unroll
            for (int r = 0; r < 16; ++r) { sA[r] = __builtin_amdgcn_exp2f(sA[r] - mn); sB[r] = __builtin_amdgcn_exp2f(sB[r] - mn); ps += sA[r] + sB[r]; }
            l = l * alpha + ps;
#pragma unroll
            for (int r = 0; r < 16; ++r) { o0[r] *= alpha; o1[r] *= alpha; }
            bf16x8 pk[4];
            { u32x4 w;
              w.x = cvtpk(sA[0], sA[1]); w.y = cvtpk(sA[2], sA[3]); w.z = cvtpk(sA[4], sA[5]); w.w = cvtpk(sA[6], sA[7]); pk[0] = __builtin_bit_cast(bf16x8, w);
              w.x = cvtpk(sA[8], sA[9]); w.y = cvtpk(sA[10], sA[11]); w.z = cvtpk(sA[12], sA[13]); w.w = cvtpk(sA[14], sA[15]); pk[1] = __builtin_bit_cast(bf16x8, w);
              w.x = cvtpk(sB[0], sB[1]); w.y = cvtpk(sB[2], sB[3]); w.z = cvtpk(sB[4], sB[5]); w.w = cvtpk(sB[6], sB[7]); pk[2] = __builtin_bit_cast(bf16x8, w);
              w.x = cvtpk(sB[8], sB[9]); w.y = cvtpk(sB[10], sB[11]); w.z = cvtpk(sB[12], sB[13]); w.w = cvtpk(sB[14], sB[15]); pk[3] = __builtin_bit_cast(bf16x8, w); }
            const LAS unsigned char* vb = lds + OFF_V + cur * TB + r32 * KP + hi * 16;
#pragma unroll
            for (int s = 0; s < 4; ++s) {
                const bf16x8 va = *(const LAS bf16x8*)(vb + s * 32);
                const bf16x8 vb2 = *(const LAS bf16x8*)(vb + 32 * KP + s * 32);
                o0 = __builtin_amdgcn_mfma_f32_32x32x16_bf16(va, pk[s], o0, 0, 0, 0);
                o1 = __builtin_amdgcn_mfma_f32_32x32x16_bf16(vb2, pk[s], o1, 0, 0, 0);
            }
        }
        asm volatile("s_waitcnt lgkmcnt(0)\n\ts_barrier" ::: "memory");
    }
    const float lt = l + __shfl_xor(l, 32);
    const float inv = 1.0f / lt;
    bf16_t* op = AO + (size_t)(rowbase + qw + r32) * PITCH_O + ocol + 4 * hi;
#pragma unroll
    for (int g4 = 0; g4 < 4; ++g4) {
        u32x2 w0, w1;
        w0.x = cvtpk(o0[4 * g4] * inv, o0[4 * g4 + 1] * inv); w0.y = cvtpk(o0[4 * g4 + 2] * inv, o0[4 * g4 + 3] * inv);
        w1.x = cvtpk(o1[4 * g4] * inv, o1[4 * g4 + 1] * inv); w1.y = cvtpk(o1[4 * g4 + 2] * inv, o1[4 * g4 + 3] * inv);
        *(u32x2*)(op + 8 * g4) = w0; *(u32x2*)(op + 32 + 8 * g4) = w1;
    }
}
}

typedef unsigned short bf16;
typedef unsigned v4u __attribute__((ext_vector_type(4)));
typedef unsigned v2u __attribute__((ext_vector_type(2)));
typedef float f32x4 __attribute__((ext_vector_type(4)));
constexpr int NWAVES = 8;
#ifndef DUP_ATT
#define DUP_ATT 1
#endif
#ifndef DUP_FFN1
#define DUP_FFN1 1
#endif
#ifndef DUP_LN
#define DUP_LN 1
#endif
#ifndef DUP_PRO
#define DUP_PRO 1
#endif
#ifndef DUP_P1
#define DUP_P1 1
#endif
#ifndef DUP_OP
#define DUP_OP 1
#endif
#ifndef DUP_DN
#define DUP_DN 1
#endif
constexpr int DM = 1024, DIN = 1536, DFF = 2816, DEPTH = 4, MTOT = 65536, MHALF = 32768, NPROJ = 1280;
constexpr size_t MiB = 1u << 20;
constexpr size_t WS_ROPE = 0;
constexpr size_t WS_LUT = 32768;
constexpr size_t WS_STATS = 256 * 1024;
constexpr size_t WS_W = 1 * MiB;
constexpr size_t W_P = 0, W_V = W_P + (size_t)1280 * 1024, W_O = W_V + (size_t)256 * 1024, W_GU = W_O + (size_t)1024 * 1024, W_D = W_GU + (size_t)5632 * 1024, W_LAYER = W_D + (size_t)1024 * 2816;
constexpr size_t WS_XB = 88 * MiB;
constexpr size_t WS_PROJ = 216 * MiB;
constexpr size_t WS_VT = 376 * MiB;
constexpr size_t WS_H = 216 * MiB;
constexpr size_t WS_MX0 = 408 * MiB;
constexpr size_t WS_END = 472 * MiB;
static_assert(W_LAYER * 2 * 3 >= (size_t)MHALF * DM * 2 && WS_W + W_LAYER * 2 * DEPTH <= WS_XB && WS_H + (size_t)MHALF * DFF * 2 <= WS_END, "ws map");
constexpr int LDS_BYTES = 135168;

constexpr size_t WS_BAR = 65536;
#define XB_TMO      128
#define XB_XCNT(j)  (256  + 64 * (j))
#define XB_XSUB(j)  (1280 + 64 * (j))
#define XB_XGEN(j)  (2304 + 64 * (j))
#define XB_TOP      3328
#define XB_TOPGEN   3392
#define XCD_BAR_WORDS 3456
#define XB_SPIN_CAP (1u << 18)

__device__ __forceinline__ unsigned xb_ld(unsigned* p)              { return __hip_atomic_load(p, __ATOMIC_RELAXED, __HIP_MEMORY_SCOPE_AGENT); }
__device__ __forceinline__ unsigned xb_add(unsigned* p, unsigned v) { return __hip_atomic_fetch_add(p, v, __ATOMIC_RELAXED, __HIP_MEMORY_SCOPE_AGENT); }
__device__ __forceinline__ unsigned xb_xcc_id() { return (unsigned)__builtin_amdgcn_s_getreg((3 << 11) | 20) & 0xFu; }
#define XB_SPIN(cond, bar) do { unsigned _sp = 0; while (cond) { __builtin_amdgcn_s_sleep(1); \
    if ((++_sp & 255u) == 0u) { if (xb_ld(&(bar)[XB_TMO])) break; if (_sp > XB_SPIN_CAP) { atomicAdd(&(bar)[XB_TMO], 1u); break; } } } } while (0)

struct XcdBarrier {
    unsigned* bar; unsigned x;
    volatile LAS unsigned* st;
};

__device__ __forceinline__ XcdBarrier xcd_barrier_post(unsigned* bar, volatile LAS unsigned* st) {
    XcdBarrier b; b.bar = bar; b.x = xb_xcc_id(); b.st = st;
    if (threadIdx.x == 0) (void)xb_add(&bar[XB_XCNT(b.x)], 1u);
    return b;
}
__device__ __forceinline__ void xcd_barrier_complete(unsigned* bar, unsigned x, unsigned& nloc, unsigned& nx) {
    const unsigned G = gridDim.x * gridDim.y * gridDim.z;
    unsigned sum, cnt, mine, sp = 0u;
    for (;;) {
        sum = 0u; cnt = 0u; mine = 0u;
#pragma unroll
        for (unsigned j = 0; j < 16; ++j) { const unsigned c = xb_ld(&bar[XB_XCNT(j)]); sum += c; cnt += (c > 0u) ? 1u : 0u; mine = (j == x) ? c : mine; }
        if (sum == G) break;
        __builtin_amdgcn_s_sleep(1);
        if ((++sp & 255u) == 0u) { if (xb_ld(&bar[XB_TMO])) break; if (sp > XB_SPIN_CAP) { atomicAdd(&bar[XB_TMO], 1u); break; } }
    }
    nloc = mine > 0u ? mine : 1u; nx = cnt > 0u ? cnt : 1u;
}

__device__ __forceinline__ void xcd_barrier(const XcdBarrier& b) {
    asm volatile("s_waitcnt vmcnt(0)" ::: "memory");
    __syncthreads();
    if (threadIdx.x == 0) {
        unsigned* bar = b.bar;
        __builtin_amdgcn_s_waitcnt(0);
        unsigned nloc = b.st[0], nx = b.st[1];
        if (nloc == 0u) { xcd_barrier_complete(bar, b.x, nloc, nx); b.st[0] = nloc; b.st[1] = nx; }
        const unsigned old = xb_add(&bar[XB_XSUB(b.x)], 1u);
        const unsigned gen = old / nloc;
        if (old + 1u == (gen + 1u) * nloc) {
            __builtin_amdgcn_fence(__ATOMIC_RELEASE, "agent");
            asm volatile("s_waitcnt vmcnt(0)" ::: "memory");
            const unsigned og = xb_add(&bar[XB_TOP], 1u);
            const unsigned tg = og / nx;
            if (og + 1u == (tg + 1u) * nx) xb_add(&bar[XB_TOPGEN], 1u);
            else XB_SPIN(xb_ld(&bar[XB_TOPGEN]) == tg, bar);
            __builtin_amdgcn_fence(__ATOMIC_ACQUIRE, "agent");
            xb_add(&bar[XB_XGEN(b.x)], 1u);
            asm volatile("s_waitcnt vmcnt(0)" ::: "memory");
        } else {
            XB_SPIN(xb_ld(&bar[XB_XGEN(b.x)]) == gen, bar);
            __builtin_amdgcn_fence(__ATOMIC_ACQUIRE, "agent");
            asm volatile("s_waitcnt vmcnt(0)" ::: "memory");
        }
    }
    __syncthreads();
}

struct Args { const float* in[15]; float* out; unsigned char* ws; int ph_lo, ph_hi; };

__device__ __forceinline__ unsigned f2bf(float f) { unsigned u = __builtin_bit_cast(unsigned, f); return (u + 0x7fffu + ((u >> 16) & 1u)) >> 16; }
__device__ __forceinline__ unsigned pk2(float lo, float hi) { return f2bf(lo) | (f2bf(hi) << 16); }
typedef _Float16 h16x2 __attribute__((ext_vector_type(2))); typedef _Float16 h16x4 __attribute__((ext_vector_type(4))); typedef float f32x2p __attribute__((ext_vector_type(2)));
__device__ __forceinline__ unsigned pkh(float lo, float hi) { f32x2p v = {lo, hi}; return __builtin_bit_cast(unsigned, __builtin_convertvector(v, h16x2)); }
template <bool H> __device__ __forceinline__ unsigned pk16(float lo, float hi) { return H ? pkh(lo, hi) : pk2(lo, hi); }
__device__ __forceinline__ float wave_sum(float v) {
#pragma unroll
    for (int o = 1; o < 64; o <<= 1) v += __shfl_xor(v, o);
    return v;
}
template <bool H>
__device__ __forceinline__ void transpose_item(const float* __restrict__ W, int ldw, int col0, int k0, bf16* __restrict__ WT, int K, int n0, LAS float* scr, int lane) {
#pragma unroll 8
    for (int i = 0; i < 32; ++i) { const int kk = 2 * i + (lane >> 5); scr[kk * 33 + (lane & 31)] = W[(size_t)(k0 + kk) * ldw + col0 + (lane & 31)]; }
    asm volatile("s_waitcnt lgkmcnt(0)" ::: "memory");
    const int c = lane & 7;
#pragma unroll
    for (int j = 0; j < 4; ++j) { const int n = (lane >> 3) + 8 * j; const LAS float* s = scr + (8 * c) * 33 + n;
        v4u o; o.x = pk16<H>(s[0 * 33], s[1 * 33]); o.y = pk16<H>(s[2 * 33], s[3 * 33]); o.z = pk16<H>(s[4 * 33], s[5 * 33]); o.w = pk16<H>(s[6 * 33], s[7 * 33]);
        *(v4u*)(WT + (size_t)(n0 + n) * K + k0 + 8 * c) = o; }
    asm volatile("s_waitcnt lgkmcnt(0)" ::: "memory");
}

typedef const __attribute__((address_space(4))) Args* CArgsP;
__device__ __forceinline__ void prologue(CArgsP ap_, LAS unsigned char* lds, int gw, int ngw, int wave, int lane) {
    Args a;
#pragma unroll
    for (int i = 0; i < 15; ++i) a.in[i] = ap_->in[i];
    a.out = ap_->out; a.ws = ap_->ws; a.ph_lo = 0; a.ph_hi = 0;
    unsigned char* ws = a.ws;
    LAS float* scr = (LAS float*)(lds + wave * 16384);
    constexpr int I_P = 16 * 40, I_V = 16 * 8, I_O = 16 * 32, I_GU = 16 * 176, I_D = 44 * 32, I_LAYER = I_P + I_V + I_O + I_GU + I_D;
    for (int it = gw; it < I_LAYER * DEPTH; it += ngw) {
        const int l = it / I_LAYER; int r = it % I_LAYER;
        bf16* wl = (bf16*)(ws + WS_W) + (size_t)l * W_LAYER;
        const float* w_in = a.in[3] + (size_t)l * DM * DIN;
        if (r < I_P) { const int kb = r / 40, nb = r % 40, tile = nb >> 3, r8 = nb & 7, bj = r8 >> 2, wc = r8 & 3; int col;
            if (tile < 2) col = (4 * tile + wc) * 64 + 32 * bj;
            else if (tile < 4) col = 768 + (4 * (tile - 2) + wc) * 64 + 32 * bj;
            else if (wc < 2) col = 512 + wc * 64 + 32 * bj;
            else col = 1280 + (wc - 2) * 64 + 32 * bj;
            transpose_item<true>(w_in, DIN, col, kb * 64, wl + W_P, DM, nb * 32, scr, lane); continue; }
        r -= I_P;
        if (r < I_V) { const int kb = r / 8, nb = r % 8; const int col = nb < 4 ? 640 + 32 * nb : 1408 + 32 * (nb - 4);
            transpose_item<true>(w_in, DIN, col, kb * 64, wl + W_V, DM, nb * 32, scr, lane); continue; }
        r -= I_V;
        if (r < I_O) { const int kb = r / 32, nb = r % 32;
            transpose_item<false>(a.in[4] + (size_t)l * DM * DM, DM, nb * 32, kb * 64, wl + W_O, DM, nb * 32, scr, lane); continue; }
        r -= I_O;
        if (r < I_GU) { const int kb = r / 176, nb = r % 176, pn = nb >> 3, r8 = nb & 7;
            const float* src = (r8 < 4 ? a.in[10] : a.in[11]) + (size_t)l * DM * DFF;
            transpose_item<true>(src, DFF, 128 * pn + 32 * (r8 & 3), kb * 64, wl + W_GU, DM, nb * 32, scr, lane); continue; }
        r -= I_GU;
        { const int kb = r / 32, nb = r % 32;
            transpose_item<false>(a.in[12] + (size_t)l * DFF * DM, DM, nb * 32, kb * 64, wl + W_D, DFF, nb * 32, scr, lane); }
    }
    bf16* XB = (bf16*)(ws + WS_XB);
    for (int row = gw; row < MTOT; row += ngw) {
        const float* src = row < MHALF ? a.in[0] + (size_t)row * DM : a.in[1] + (size_t)(row - MHALF) * DM;
        const f32x4* xr = (const f32x4*)src + lane; v2u* ob = (v2u*)(XB + (size_t)row * DM) + lane;
#pragma unroll
        for (int j = 0; j < 4; ++j) { const f32x4 v = xr[64 * j]; v2u w; w.x = pkh(v[0], v[1]); w.y = pkh(v[2], v[3]); ob[64 * j] = w; }
    }
    const int gt = gw * 64 + lane, ngt = ngw * 64;
    float* rope = (float*)(ws + WS_ROPE);
    for (int i = gt; i < 128 * 16; i += ngt) { const int pos = i >> 4, j = i & 15;
        const float inv = powf(10000.0f, -(float)(2 * j) / 32.0f); const float ang = (float)pos * inv;
        rope[2 * i] = cosf(ang); rope[2 * i + 1] = sinf(ang); }
    float* lutg = (float*)(ws + WS_LUT);
    for (int i = gt; i < 8 * 260; i += ngt) { const int h = i / 260, idx = i % 260; float v = 0.f;
        if (idx <= 256) { const int rel = idx - 128; const int n = rel < 0 ? -rel : rel; int bucket = rel > 0 ? 16 : 0;
            int large = 8 + (n >= 12) + (n >= 16) + (n >= 23) + (n >= 32) + (n >= 46) + (n >= 64) + (n >= 91); large = large > 15 ? 15 : large;
            bucket += n < 8 ? n : large; v = a.in[2][bucket * 8 + h] * LOG2E_F; }
        lutg[i] = v; }
}

__device__ __forceinline__ f32x4 bf4(v2u m) { f32x4 f; f[0] = __builtin_bit_cast(float, m.x << 16); f[1] = __builtin_bit_cast(float, m.x & 0xffff0000u); f[2] = __builtin_bit_cast(float, m.y << 16); f[3] = __builtin_bit_cast(float, m.y & 0xffff0000u); return f; }
__device__ __forceinline__ f32x4 h4(v2u m) { const h16x4 h = __builtin_bit_cast(h16x4, m); return __builtin_convertvector(h, f32x4); }
template <bool FINAL>
__device__ __forceinline__ void ln_phase(float* OUT, const bf16* MXlo, const bf16* MXhi, bf16* XB, const float* __restrict__ g, const float* __restrict__ b, int gw, int ngw, int lane) {
    constexpr int R = 4;
    for (int row0 = gw; row0 < MTOT; row0 += R * ngw) {
        f32x4 v[R][4];
#pragma unroll
        for (int r = 0; r < R; ++r) { const int row = row0 + r * ngw; if (row < MTOT) {
            const v2u* xr = (const v2u*)(XB + (size_t)row * DM) + lane; const v2u* mr = (const v2u*)((row < MHALF ? MXlo : MXhi) + (size_t)row * DM) + lane;
#pragma unroll
            for (int j = 0; j < 4; ++j) v[r][j] = h4(xr[64 * j]) * ALPHA_DN + bf4(mr[64 * j]); } }
#pragma unroll
        for (int r = 0; r < R; ++r) { const int row = row0 + r * ngw; if (row < MTOT) {
            f32x4* orow = (f32x4*)(OUT + (size_t)row * DM) + lane; v2u* ob = (v2u*)(XB + (size_t)row * DM) + lane;
            float s = 0.f;
#pragma unroll
            for (int j = 0; j < 4; ++j) s += (v[r][j][0] + v[r][j][1]) + (v[r][j][2] + v[r][j][3]);
            const float mean = wave_sum(s) * (1.f / DM); float s2 = 0.f;
#pragma unroll
            for (int j = 0; j < 4; ++j) { v[r][j] = v[r][j] - mean; s2 += (v[r][j][0] * v[r][j][0] + v[r][j][1] * v[r][j][1]) + (v[r][j][2] * v[r][j][2] + v[r][j][3] * v[r][j][3]); }
            const float rstd = 1.f / sqrtf(wave_sum(s2) * (1.f / DM) + 1e-5f);
#pragma unroll
            for (int j = 0; j < 4; ++j) { const f32x4 y = v[r][j] * rstd * ((const f32x4*)g)[lane + 64 * j] + ((const f32x4*)b)[lane + 64 * j];
                if (FINAL) orow[64 * j] = y; else { v2u w; w.x = pkh(y[0], y[1]); w.y = pkh(y[2], y[3]); ob[64 * j] = w; } } } }
    }
}

typedef const __attribute__((address_space(4))) Args* CArgs;
__device__ __forceinline__ CArgs argp() { CArgs p = (CArgs)__builtin_amdgcn_kernarg_segment_ptr(); asm volatile("" : "+s"(p)); return p; }
struct Ids { int lane, wave, G, bx, vcu, gw, ngw; };
__device__ __forceinline__ Ids ids() { Ids r; int tid_ = threadIdx.x; asm volatile("" : "+v"(tid_)); r.lane = tid_ & 63; r.wave = __builtin_amdgcn_readfirstlane(tid_ >> 6);
    int g_ = gridDim.x, b_ = blockIdx.x; asm volatile("" : "+s"(g_), "+s"(b_)); r.G = g_; r.bx = b_; r.vcu = (g_ % 8 == 0) ? (b_ % 8) * (g_ / 8) + b_ / 8 : b_; r.gw = r.vcu * NWAVES + r.wave; r.ngw = g_ * NWAVES; return r; }

__global__ void __launch_bounds__(NWAVES * 64, 2) mega_fwd(Args a_unused) {
    extern __shared__ __attribute__((aligned(16))) unsigned char lds_raw[];
    LAS unsigned char* lds = (LAS unsigned char*)lds_raw;
    cg::grid_group grid = cg::this_grid();
    volatile LAS unsigned* bst = (volatile LAS unsigned*)(lds + 131072);
    if (threadIdx.x < 2) bst[threadIdx.x] = 0u;
    __syncthreads();
    (void)xcd_barrier_post((unsigned*)(argp()->ws + WS_BAR), bst);
    const int ph_lo = argp()->ph_lo, ph_hi = argp()->ph_hi;
    int ph = 0;
#define PH_ON (ph >= ph_lo && ph < ph_hi)
#define PH_END do { if (ph >= ph_lo && ph + 1 < ph_hi) { if (ph == 0) grid.sync(); else { XcdBarrier xb_; xb_.bar = (unsigned*)(argp()->ws + WS_BAR); xb_.x = xb_xcc_id(); xb_.st = bst; xcd_barrier(xb_); } } ++ph; } while (0)

    if (PH_ON) {
#pragma unroll 1
        for (int rep_ = 0; rep_ < DUP_PRO; ++rep_) { const Ids I = ids(); prologue(argp(), lds, I.gw, I.ngw, I.wave, I.lane); } }
    PH_END;
#pragma unroll 1
    for (int l = 0; l < DEPTH; ++l) {
        if (PH_ON) {
#pragma unroll 1
            for (int rep_ = 0; rep_ < DUP_P1; ++rep_) {
            const Ids I = ids(); CArgs ap = argp(); unsigned char* ws = ap->ws;
            const bf16* wl = (const bf16*)(ws + WS_W) + (size_t)l * W_LAYER; bf16* XB = (bf16*)(ws + WS_XB);
            { pg8::Gemm g{XB, wl + W_P, MTOT, NPROJ, DM}; pg8::StaticOrder S; S.init(MTOT, NPROJ, I.G, I.bx);
              pg8::EpiProj E{(bf16*)(ws + WS_PROJ), ap->in[6] + l * 64, ap->in[7] + l * 64, (const float*)(ws + WS_ROPE)};
              pg8::gemm_phase<pg8::EpiProj, pg8::StaticOrder, true, true, true>(lds, g, S, E); }
            { pg8::Gemm g{wl + W_V, XB, 256, MTOT, DM}; pg8::StaticOrder S; S.init(256, MTOT, I.G, I.bx);
              pg8::EpiVT E{(bf16*)(ws + WS_VT)};
              pg8::gemm_phase<pg8::EpiVT, pg8::StaticOrder, true, true, true>(lds, g, S, E); }
            }
        }
        PH_END;
        if (PH_ON) {
            const Ids I = ids(); CArgs ap = argp(); unsigned char* ws = ap->ws;
            const bf16* PROJ = (const bf16*)(ws + WS_PROJ); const bf16* VT = (const bf16*)(ws + WS_VT); bf16* AO = (bf16*)ap->out;   const float* lutg = (const float*)(ws + WS_LUT);
            const float* sinkp = ap->in[5] + l * 8;
            float gq = fabsf(ap->in[6][l * 64 + I.lane]), gk = fabsf(ap->in[7][l * 64 + I.lane]);
#pragma unroll
            for (int o_ = 1; o_ < 64; o_ <<= 1) { gq = fmaxf(gq, __shfl_xor(gq, o_)); gk = fmaxf(gk, __shfl_xor(gk, o_)); }
            const float bound2 = 64.0f * QSCALE_F * gq * gk * 1.01f;
            if (bound2 <= 100.0f) {
#pragma unroll 1
            for (int rep_ = 0; rep_ < DUP_ATT; ++rep_)
#pragma unroll 1
            for (int u = I.vcu; u < 4096; u += I.G) {
                const int kind = u >> 10, idx = u & 1023; const bool sample = kind & 1, win = kind >= 2;
                const int S = sample ? 8192 : 4096, nqb = S >> 8, per = 4 * nqb;
                const int bk = idx / per, rem = idx % per, b = bk >> 1, kvh = bk & 1, hq = kvh * 4 + rem / nqb, qb = rem % nqb;
                const int rowbase = (sample ? MHALF : 0) + b * S;
                if (win) att::attn_win(lds, PROJ, VT, AO, rowbase, S, kvh, rem * 64, lutg, sinkp);
                else att::attn_global(lds, PROJ, VT, AO, rowbase, S, hq, qb * 256, bound2);
            }
            } else {
#pragma unroll 1
            for (int u = I.vcu; u < 4096; u += I.G) {
                const int kind = u >> 10, idx = u & 1023; const bool sample = kind & 1, win = kind >= 2;
                const int S = sample ? 8192 : 4096, nqb = S >> 8, per = 4 * nqb;
                const int bk = idx / per, rem = idx % per, b = bk >> 1, kvh = bk & 1, hq = kvh * 4 + rem / nqb, qb = rem % nqb;
                const int rowbase = (sample ? MHALF : 0) + b * S;
                if (win) att::attn_unit<1>(lds, PROJ, VT, AO, rowbase, S, hq, qb * 256, lutg + hq * 260, sinkp[hq] * LOG2E_F);
                else att::attn_unit<0>(lds, PROJ, VT, AO, rowbase, S, hq, qb * 256, lutg, bound2);
            }
            }
        }
        PH_END;
        if (PH_ON) {
            const Ids I = ids(); CArgs ap = argp(); unsigned char* ws = ap->ws;
            const bf16* wl = (const bf16*)(ws + WS_W) + (size_t)l * W_LAYER;
            pg8::Gemm g{(const bf16*)ap->out, wl + W_O, MTOT, DM, DM}; pg8::StaticOrder S; S.init(MTOT, DM, I.G, I.bx);
            pg8::EpiBf16 E{(bf16*)(ws + WS_PROJ), DM};
#pragma unroll 1
            for (int rep_ = 0; rep_ < DUP_OP; ++rep_)
            pg8::gemm_phase<pg8::EpiBf16, pg8::StaticOrder, true, true>(lds, g, S, E);
        }
        PH_END;
        if (PH_ON) { const Ids I = ids(); CArgs ap = argp(); const bf16* mx = (const bf16*)(ap->ws + WS_PROJ);
            ln_phase<false>(ap->out, mx, mx, (bf16*)(ap->ws + WS_XB), ap->in[8] + l * DM, ap->in[9] + l * DM, I.gw, I.ngw, I.lane); }
        PH_END;
#pragma unroll 1
        for (int half = 0; half < 2; ++half) {
            if (PH_ON) {
                const Ids I = ids(); CArgs ap = argp(); unsigned char* ws = ap->ws;
                const bf16* wl = (const bf16*)(ws + WS_W) + (size_t)l * W_LAYER;
                pg8::Gemm g{(const bf16*)(ws + WS_XB) + (size_t)half * MHALF * DM, wl + W_GU, MHALF, 2 * DFF, DM}; pg8::StaticOrder S; S.init(MHALF, 2 * DFF, I.G, I.bx);
                pg8::EpiSwiGLU E{(bf16*)(ws + WS_H), DFF};
#pragma unroll 1
                for (int rep_ = 0; rep_ < DUP_FFN1; ++rep_)
                pg8::gemm_phase<pg8::EpiSwiGLU, pg8::StaticOrder, true, true, true>(lds, g, S, E);
            }
            PH_END;
            if (PH_ON) {
                const Ids I = ids(); CArgs ap = argp(); unsigned char* ws = ap->ws;
                const bf16* wl = (const bf16*)(ws + WS_W) + (size_t)l * W_LAYER;
                pg8::Gemm g{(const bf16*)(ws + WS_H), wl + W_D, MHALF, DM, DFF}; pg8::StaticOrder S; S.init(MHALF, DM, I.G, I.bx);
                pg8::EpiBf16 E{half == 0 ? (bf16*)(ws + WS_MX0) : (l < DEPTH - 1 ? (bf16*)((char*)ap->out + 128 * MiB) : (bf16*)(ws + WS_W)), DM};
#pragma unroll 1
                for (int rep_ = 0; rep_ < DUP_DN; ++rep_)
                pg8::gemm_phase<pg8::EpiBf16, pg8::StaticOrder, true, true>(lds, g, S, E);
            }
            PH_END;
        }
        if (PH_ON) { const Ids I = ids(); CArgs ap = argp(); const bf16* mlo = (const bf16*)(ap->ws + WS_MX0); bf16* xb = (bf16*)(ap->ws + WS_XB);
            const bf16* mhi = (l < DEPTH - 1 ? (const bf16*)((const char*)ap->out + 128 * MiB) : (const bf16*)(ap->ws + WS_W)) - (size_t)MHALF * DM;
            if (l == DEPTH - 1) ln_phase<true>(ap->out, mlo, mhi, xb, ap->in[13] + l * DM, ap->in[14] + l * DM, I.gw, I.ngw, I.lane);
            else ln_phase<false>(ap->out, mlo, mhi, xb, ap->in[13] + l * DM, ap->in[14] + l * DM, I.gw, I.ngw, I.lane); }
        PH_END;
    }
}
constexpr int N_PHASES = 1 + DEPTH * 9;

#ifndef MK_MULTI
#define MK_MULTI 0
#endif
extern "C" void kernel_launch(void* const* d_in, const int* in_sizes, int n_in, void* d_out, int out_size, void* d_ws, size_t ws_size, hipStream_t stream) {
    static int grid = 0;
    if (grid == 0) {
        if (n_in != 15 || out_size != MTOT * DM || ws_size < WS_END) { fprintf(stderr, "kernel_launch: unexpected shapes: n_in %d out %d ws %zu (need %zu)\n", n_in, out_size, ws_size, (size_t)WS_END); grid = -1; return; }
        int dev = 0, cus = 0, per_cu = 0;
        hipGetDevice(&dev); hipDeviceGetAttribute(&cus, hipDeviceAttributeMultiprocessorCount, dev);
        if (hipFuncSetAttribute((const void*)mega_fwd, hipFuncAttributeMaxDynamicSharedMemorySize, LDS_BYTES) != hipSuccess) { fprintf(stderr, "kernel_launch: hipFuncSetAttribute failed\n"); grid = -1; return; }
        if (hipOccupancyMaxActiveBlocksPerMultiprocessor(&per_cu, (const void*)mega_fwd, NWAVES * 64, LDS_BYTES) != hipSuccess || per_cu < 1) { fprintf(stderr, "kernel_launch: occupancy query gave %d\n", per_cu); per_cu = 1; }
        (void)hipGetLastError();
        grid = cus * per_cu;
        fprintf(stderr, "kernel_launch: grid %d (cus %d x %d), ws %zu\n", grid, cus, per_cu, ws_size);
    }
    if (grid < 0) return;
    if (hipMemsetAsync((char*)d_ws + WS_BAR, 0, 16384, stream) != hipSuccess) { fprintf(stderr, "kernel_launch: memset failed\n"); return; }
    Args a{};
    for (int i = 0; i < 15; ++i) a.in[i] = (const float*)d_in[i];
    a.out = (float*)d_out; a.ws = (unsigned char*)d_ws;
#if MK_MULTI
    for (int p = 0; p < N_PHASES; ++p) { a.ph_lo = p; a.ph_hi = p + 1; hipLaunchKernelGGL(mega_fwd, dim3(grid), dim3(NWAVES * 64), LDS_BYTES, stream, a); }
#else
    a.ph_lo = 0; a.ph_hi = N_PHASES;
    void* args[] = {&a};
    hipError_t e = hipLaunchCooperativeKernel((const void*)mega_fwd, dim3(grid), dim3(NWAVES * 64), args, LDS_BYTES, stream);
    if (e != hipSuccess) fprintf(stderr, "cooperative launch failed: %s (grid %d)\n", hipGetErrorString(e), grid);
#endif
}
```

```cpp
#include <hip/hip_runtime.h>
#include <hip/hip_cooperative_groups.h>
#include <cstdio>
#include <cstdint>
namespace cg = cooperative_groups;
#define ALPHA_DN 1.681792830507429f
#define LOG2E_F 1.4426950408889634f
#define QSCALE_F (0.125f * 1.4426950408889634f)
namespace pg8 {
#define PG8_LAS __attribute__((address_space(3)))
typedef unsigned short bf16_t;
typedef short bf16x8 __attribute__((ext_vector_type(8)));
typedef float f32x4 __attribute__((ext_vector_type(4)));
typedef unsigned u32x4 __attribute__((ext_vector_type(4)));
constexpr int BM = 256, BK = 64, HALF = 128, HTB = HALF * BK * 2  , STAGE_BYTES = 8 * HTB, NXCD = 8, WGM = 8;

__host__ __device__ __forceinline__ int lds_byte(int r, int c) { const int st = (r >> 4) * 2 + (c >> 5), rr = r & 15, cc = c & 31, ob = rr * 64 + cc * 2; return st * 1024 + (ob ^ (((ob >> 9) & 1) << 5)); }
__host__ __device__ __forceinline__ void stage_rc(int b, int& R, int& C) { const int st = b / 1024, sb = b % 1024, swz = sb ^ (((sb >> 9) & 1) << 5); R = (st >> 1) * 16 + swz / 64; C = (st & 1) * 32 + (swz % 64) / 2; }
__host__ __device__ __forceinline__ int perm32(int rho) { const int n = rho >> 4, i = rho & 15; return 8 * (i >> 2) + 4 * n + (i & 3); }

struct Unit { int pm, pn; };
struct Gemm { const bf16_t* A; const bf16_t* Bt; int M, N, K; };

struct StaticOrder {
    int nM, nN, nwg, G, c;
    __host__ __device__ void init(int M, int N, int G_, int c_) { nM = M / BM; nN = N / BM; nwg = nM * nN; G = G_; c = c_; }
    __host__ __device__ bool next(int i, Unit& u) const {
        const long L = (long)i * G + c; if (L >= nwg) return false;
        int wgid = (int)L; { const int q = nwg / NXCD, r = nwg % NXCD, xcd = wgid % NXCD, off = wgid / NXCD; wgid = (xcd < r ? xcd * (q + 1) : r * (q + 1) + (xcd - r) * q) + off; }
        const int nig = WGM * nN, gid = wgid / nig, fm = gid * WGM, gsz = (nM - fm) < WGM ? (nM - fm) : WGM;
        u.pm = fm + ((wgid % nig) % gsz); u.pn = (wgid % nig) / gsz; return true;
    }
    __device__ __forceinline__ void a_ready(const Unit&) const {}
    __device__ __forceinline__ void done(const Unit&) const {}
};

__device__ __forceinline__ unsigned cvt_pk_bf16(float lo, float hi) { unsigned r; asm volatile("v_cvt_pk_bf16_f32 %0, %1, %2" : "=v"(r) : "v"(lo), "v"(hi)); return r; }
struct EpiBf16 {
    static constexpr bool PERM = true, AFTER_DRAIN = false;
    bf16_t* O; int ldc;
    __device__ __forceinline__ void operator()(const f32x4 (&acc)[2][2][4][2], const Unit& u, int wr, int wc, int fr, int fq) const {
        const int row0 = u.pm * BM + wr * 64 + fr; const int col0 = u.pn * BM + wc * 32 + 8 * fq;
#pragma unroll
        for (int ai = 0; ai < 2; ++ai)
#pragma unroll
            for (int m = 0; m < 4; ++m) { bf16_t* rowp = O + (size_t)(row0 + ai * HALF + m * 16) * ldc + col0;
#pragma unroll
                for (int bj = 0; bj < 2; ++bj) { const f32x4 v0 = acc[ai][bj][m][0], v1 = acc[ai][bj][m][1];
                    u32x4 w; w.x = cvt_pk_bf16(v0[0], v0[1]); w.y = cvt_pk_bf16(v0[2], v0[3]); w.z = cvt_pk_bf16(v1[0], v1[1]); w.w = cvt_pk_bf16(v1[2], v1[3]);
                    *(u32x4*)(rowp + bj * HALF) = w; } }
    }
};
struct EpiVT {
    static constexpr bool PERM = true, AFTER_DRAIN = false;
    bf16_t* O;
    __device__ __forceinline__ void operator()(const f32x4 (&acc)[2][2][4][2], const Unit& u, int wr, int wc, int fr, int fq) const {
        const int row0 = wr * 64 + fr; const int col0 = u.pn * BM + wc * 32 + 8 * fq;
#pragma unroll
        for (int bj = 0; bj < 2; ++bj) { const int tok = col0 + bj * HALF; bf16_t* tp = O + (size_t)(tok >> 6) * (256 * 64) + (tok & 63);
#pragma unroll
            for (int ai = 0; ai < 2; ++ai)
#pragma unroll
                for (int m = 0; m < 4; ++m) { const f32x4 v0 = acc[ai][bj][m][0], v1 = acc[ai][bj][m][1];
                    u32x4 w; w.x = cvt_pk_bf16(v0[0], v0[1]); w.y = cvt_pk_bf16(v0[2], v0[3]); w.z = cvt_pk_bf16(v1[0], v1[1]); w.w = cvt_pk_bf16(v1[2], v1[3]);
                    *(u32x4*)(tp + (row0 + ai * HALF + m * 16) * 64) = w; } }
    }
};
struct EpiSwiGLU {
    static constexpr bool PERM = true, AFTER_DRAIN = false;
    bf16_t* O; int ldc;
    __device__ __forceinline__ void operator()(const f32x4 (&acc)[2][2][4][2], const Unit& u, int wr, int wc, int fr, int fq) const {
        const int row0 = u.pm * BM + wr * 64 + fr; const int col0 = u.pn * HALF + wc * 32 + 8 * fq;
#pragma unroll
        for (int ai = 0; ai < 2; ++ai)
#pragma unroll
            for (int m = 0; m < 4; ++m) { bf16_t* rowp = O + (size_t)(row0 + ai * HALF + m * 16) * ldc + col0;
                float h[8];
#pragma unroll
                for (int n = 0; n < 2; ++n)
#pragma unroll
                    for (int j = 0; j < 4; ++j) { const float g = acc[ai][0][m][n][j], up = acc[ai][1][m][n][j];
                        const float e = __builtin_amdgcn_exp2f(-g * LOG2E_F); h[n * 4 + j] = g * __builtin_amdgcn_rcpf(1.0f + e) * up; }
                u32x4 w; w.x = cvt_pk_bf16(h[0], h[1]); w.y = cvt_pk_bf16(h[2], h[3]); w.z = cvt_pk_bf16(h[4], h[5]); w.w = cvt_pk_bf16(h[6], h[7]);
                *(u32x4*)rowp = w; }
    }
};
struct EpiProj {
    static constexpr bool PERM = true, AFTER_DRAIN = false;
    bf16_t* O; const float* qg; const float* kg; const float* rope;
    __device__ __forceinline__ void operator()(const f32x4 (&acc)[2][2][4][2], const Unit& u, int wr, int wc, int fr, int fq) const {
        const int pn = u.pn; int ocol; const float* g = nullptr; float sc = 1.f;
        if (pn < 2) { ocol = (4 * pn + wc) * 64; sc = QSCALE_F; }
        else if (pn < 4) { ocol = 512 + (4 * (pn - 2) + wc) * 64; g = qg; sc = QSCALE_F; }
        else if (wc < 2) { ocol = 1024 + wc * 64; }
        else { ocol = 1152 + (wc - 2) * 64; g = kg; }
        const int row0 = u.pm * BM + wr * 64 + fr;
        if (g == nullptr) {
#pragma unroll
            for (int ai = 0; ai < 2; ++ai)
#pragma unroll
                for (int m = 0; m < 4; ++m) { bf16_t* rowp = O + (size_t)(row0 + ai * HALF + m * 16) * 1280 + ocol + 8 * fq;
#pragma unroll
                    for (int bj = 0; bj < 2; ++bj) { const f32x4 v0 = acc[ai][bj][m][0] * sc, v1 = acc[ai][bj][m][1] * sc;
                        u32x4 w; w.x = cvt_pk_bf16(v0[0], v0[1]); w.y = cvt_pk_bf16(v0[2], v0[3]); w.z = cvt_pk_bf16(v1[0], v1[1]); w.w = cvt_pk_bf16(v1[2], v1[3]);
                        *(u32x4*)(rowp + bj * 32) = w; } }
        } else {
            f32x4 gv[2][2];
#pragma unroll
            for (int bj = 0; bj < 2; ++bj)
#pragma unroll
                for (int n = 0; n < 2; ++n) gv[bj][n] = *(const f32x4*)(g + 32 * bj + 8 * fq + 4 * n) * sc;
#pragma unroll
            for (int ai = 0; ai < 2; ++ai)
#pragma unroll
                for (int m = 0; m < 4; ++m) { const int row = row0 + ai * HALF + m * 16; bf16_t* rowp = O + (size_t)row * 1280 + ocol + 8 * fq;
                    float ss = 0.f;
#pragma unroll
                    for (int bj = 0; bj < 2; ++bj)
#pragma unroll
                        for (int n = 0; n < 2; ++n) { const f32x4 v = acc[ai][bj][m][n]; ss += (v[0] * v[0] + v[1] * v[1]) + (v[2] * v[2] + v[3] * v[3]); }
                    ss += __shfl_xor(ss, 16); ss += __shfl_xor(ss, 32);
                    const float rinv = 1.0f / sqrtf(ss * (1.0f / 64.0f) + 1e-6f);
                    const int spos = row & (row < 32768 ? 4095 : 8191);
#pragma unroll
                    for (int bj = 0; bj < 2; ++bj) { const int pos = bj == 0 ? (spos >> 6) : (spos & 63); f32x4 o[2];
#pragma unroll
                        for (int n = 0; n < 2; ++n) { const f32x4 cs = *(const f32x4*)(rope + (pos * 16 + 4 * fq + 2 * n) * 2);
                            const f32x4 y = acc[ai][bj][m][n] * rinv * gv[bj][n];
                            o[n][0] = y[0] * cs[0] - y[1] * cs[1]; o[n][1] = y[0] * cs[1] + y[1] * cs[0];
                            o[n][2] = y[2] * cs[2] - y[3] * cs[3]; o[n][3] = y[2] * cs[3] + y[3] * cs[2]; }
                        u32x4 w; w.x = cvt_pk_bf16(o[0][0], o[0][1]); w.y = cvt_pk_bf16(o[0][2], o[0][3]); w.z = cvt_pk_bf16(o[1][0], o[1][1]); w.w = cvt_pk_bf16(o[1][2], o[1][3]);
                        *(u32x4*)(rowp + bj * 32) = w; } }
        }
    }
};
typedef _Float16 f16x8 __attribute__((ext_vector_type(8)));
template <class Epi, class Sched, bool ALIGN_EPI = false, bool SP2 = false, bool F16 = false>
__device__ __forceinline__ void gemm_phase(PG8_LAS unsigned char* lds, const Gemm g, const Sched& S, const Epi& E) {
    int tid_ = threadIdx.x; asm volatile("" : "+v"(tid_));
    const int tid = tid_, wid = __builtin_amdgcn_readfirstlane(tid >> 6), lane = tid & 63, wr = wid >> 2, wc = wid & 3, fr = lane & 15, fq = lane >> 4;
    const int K = g.K, nt = K / BK;
    unsigned voffA[2], voffB[2];
#pragma unroll
    for (int i = 0; i < 2; ++i) { int R, C; stage_rc(tid * 16 + i * 8192, R, C); const int Rb = Epi::PERM ? ((R & ~31) + perm32(R & 31)) : R;
        voffA[i] = (unsigned)(R * K + C) * 2u; voffB[i] = (unsigned)(Rb * K + C) * 2u; }
    const size_t kstep = (size_t)(BK * 2);
    const size_t hstep = (size_t)HALF * K * 2;
    const size_t tstep = 2 * hstep;
    const unsigned ldsw = (unsigned)wid * 1024u;
    const int aoff = lds_byte(wr * 64 + fr, fq * 8), boff = lds_byte(wc * 32 + fr, fq * 8);
#define PG8_SA(b, h) (((b) * 2 + (h)) * HTB)
#define PG8_SB(b, h) ((4 + (b) * 2 + (h)) * HTB)
#define PG8_STAGE(bufoff, gbase, voff) do { _Pragma("unroll") for (int _i = 0; _i < 2; ++_i) \
        __builtin_amdgcn_global_load_lds((const unsigned*)((const char*)(gbase) + (voff)[_i]), (PG8_LAS unsigned*)(lds + (bufoff) + ldsw + _i * 8192), 16, 0, 0); } while (0)
#define PG8_LDA(dst, b, h) do { _Pragma("unroll") for (int m = 0; m < 4; ++m) _Pragma("unroll") for (int k = 0; k < 2; ++k) dst[m][k] = *(const PG8_LAS bf16x8*)(lds + PG8_SA(b, h) + aoff + m * 2048 + k * 1024); } while (0)
#define PG8_LDB(dst, b, h) do { _Pragma("unroll") for (int n = 0; n < 2; ++n) _Pragma("unroll") for (int k = 0; k < 2; ++k) dst[n][k] = *(const PG8_LAS bf16x8*)(lds + PG8_SB(b, h) + boff + n * 2048 + k * 1024); } while (0)
#define PG8_MMA(ai, bj, At, Bt) do { __builtin_amdgcn_s_setprio(1); _Pragma("unroll") for (int m = 0; m < 4; ++m) _Pragma("unroll") for (int n = 0; n < 2; ++n) _Pragma("unroll") for (int k = 0; k < 2; ++k) \
        acc[ai][bj][m][n] = F16 ? __builtin_amdgcn_mfma_f32_16x16x32_f16(__builtin_bit_cast(f16x8, Bt[n][k]), __builtin_bit_cast(f16x8, At[m][k]), acc[ai][bj][m][n], 0, 0, 0) \
                                : __builtin_amdgcn_mfma_f32_16x16x32_bf16(Bt[n][k], At[m][k], acc[ai][bj][m][n], 0, 0, 0); __builtin_amdgcn_s_setprio(0); } while (0)
#define PG8_WAIT_V(n) asm volatile("s_waitcnt vmcnt(" #n ")" ::: "memory")
#define PG8_WAIT_L(n) asm volatile("s_waitcnt lgkmcnt(" #n ")" ::: "memory")
#define PG8_BAR __builtin_amdgcn_s_barrier()
#define PG8_SCHED __builtin_amdgcn_sched_barrier(0)
    Unit cur, nxt; int ui = 0;
    if (!S.next(0, cur)) return;
    f32x4 acc[2][2][4][2];
#pragma unroll
    for (int a = 0; a < 2; ++a)
#pragma unroll
        for (int b = 0; b < 2; ++b)
#pragma unroll
            for (int m = 0; m < 4; ++m)
#pragma unroll
                for (int n = 0; n < 2; ++n) acc[a][b][m][n] = (f32x4){0.f, 0.f, 0.f, 0.f};
    bf16x8 At[4][2], B0[2][2], B1[2][2];
    const char* cA = (const char*)g.A + (size_t)cur.pm * tstep; const char* cB = (const char*)g.Bt + (size_t)cur.pn * tstep;
    S.a_ready(cur);
    if constexpr (SP2) {
        PG8_STAGE(PG8_SB(0, 0), cB, voffB); PG8_STAGE(PG8_SB(0, 1), cB + hstep, voffB); PG8_STAGE(PG8_SA(0, 0), cA, voffA); PG8_STAGE(PG8_SA(0, 1), cA + hstep, voffA);
        if (wr == 1) PG8_BAR;
        PG8_WAIT_V(2); PG8_BAR;
        PG8_STAGE(PG8_SB(1, 0), cB + kstep, voffB); PG8_STAGE(PG8_SA(1, 0), cA + kstep, voffA); PG8_STAGE(PG8_SB(1, 1), cB + hstep + kstep, voffB);
        PG8_WAIT_V(6); PG8_BAR;
    } else {
        PG8_STAGE(PG8_SB(0, 0), cB, voffB); PG8_STAGE(PG8_SA(0, 0), cA, voffA); PG8_STAGE(PG8_SB(0, 1), cB + hstep, voffB); PG8_STAGE(PG8_SA(0, 1), cA + hstep, voffA);
        if (wr == 1) PG8_BAR;
        PG8_WAIT_V(4); PG8_BAR;
        PG8_STAGE(PG8_SB(1, 0), cB + kstep, voffB); PG8_STAGE(PG8_SA(1, 0), cA + kstep, voffA); PG8_STAGE(PG8_SB(1, 1), cB + hstep + kstep, voffB);
        PG8_WAIT_V(6); PG8_BAR;
    }
    for (;;) {
        const bool has_next = S.next(ui + 1, nxt);
        const char* nA = has_next ? (const char*)g.A + (size_t)nxt.pm * tstep : cA; const char* nB = has_next ? (const char*)g.Bt + (size_t)nxt.pn * tstep : cB;
        for (int t = 0; t < nt; t += 2) {
            const bool last = (t == nt - 2);
            const char* a1 = cA + (size_t)(t + 1) * kstep;
            const char* a2 = last ? nA : cA + (size_t)(t + 2) * kstep; const char* b2 = last ? nB : cB + (size_t)(t + 2) * kstep;
            const char* a3 = a2 + kstep; const char* b3 = b2 + kstep;
            if (last && has_next) S.a_ready(nxt);
            if constexpr (SP2) {
            PG8_LDB(B0, 0, 0); PG8_LDB(B1, 0, 1); PG8_SCHED; PG8_LDA(At, 0, 0); PG8_STAGE(PG8_SA(1, 1), a1 + hstep, voffA);
            PG8_WAIT_V(8); PG8_WAIT_L(0); PG8_BAR; PG8_MMA(0, 0, At, B0); PG8_MMA(0, 1, At, B1); PG8_BAR; PG8_SCHED;
            PG8_LDA(At, 0, 1); PG8_STAGE(PG8_SB(0, 0), b2, voffB); PG8_STAGE(PG8_SB(0, 1), b2 + hstep, voffB); PG8_STAGE(PG8_SA(0, 0), a2, voffA);
            PG8_WAIT_V(8); PG8_WAIT_L(0); PG8_BAR; PG8_MMA(1, 0, At, B0); PG8_MMA(1, 1, At, B1); PG8_BAR; PG8_SCHED;
            PG8_LDB(B0, 1, 0); PG8_LDB(B1, 1, 1); PG8_SCHED; PG8_LDA(At, 1, 0); PG8_STAGE(PG8_SA(0, 1), a2 + hstep, voffA);
            PG8_WAIT_V(8); PG8_WAIT_L(0); PG8_BAR; PG8_MMA(0, 0, At, B0); PG8_MMA(0, 1, At, B1); PG8_BAR; PG8_SCHED;
            PG8_LDA(At, 1, 1); PG8_STAGE(PG8_SB(1, 0), b3, voffB); PG8_STAGE(PG8_SB(1, 1), b3 + hstep, voffB); PG8_STAGE(PG8_SA(1, 0), a3, voffA);
            PG8_WAIT_V(8); PG8_WAIT_L(0); PG8_BAR; PG8_MMA(1, 0, At, B0); PG8_MMA(1, 1, At, B1); PG8_BAR; PG8_SCHED;
            } else {
            PG8_LDB(B0, 0, 0); PG8_SCHED; PG8_LDA(At, 0, 0); PG8_STAGE(PG8_SA(1, 1), a1 + hstep, voffA);
            PG8_WAIT_L(8); PG8_BAR; PG8_WAIT_L(0); PG8_MMA(0, 0, At, B0); PG8_BAR; PG8_SCHED;
            PG8_LDB(B1, 0, 1); PG8_STAGE(PG8_SB(0, 0), b2, voffB);
            PG8_BAR; PG8_WAIT_L(0); PG8_MMA(0, 1, At, B1); PG8_BAR;
            PG8_LDA(At, 0, 1); PG8_STAGE(PG8_SA(0, 0), a2, voffA);
            PG8_BAR; PG8_WAIT_L(0); PG8_MMA(1, 0, At, B0); PG8_BAR; PG8_SCHED;
            PG8_STAGE(PG8_SB(0, 1), b2 + hstep, voffB);
            PG8_WAIT_V(6); PG8_BAR; PG8_MMA(1, 1, At, B1); PG8_BAR;
            PG8_LDB(B0, 1, 0); PG8_SCHED; PG8_LDA(At, 1, 0); PG8_STAGE(PG8_SA(0, 1), a2 + hstep, voffA);
            PG8_WAIT_L(8); PG8_BAR; PG8_WAIT_L(0); PG8_MMA(0, 0, At, B0); PG8_BAR; PG8_SCHED;
            PG8_LDB(B1, 1, 1); PG8_STAGE(PG8_SB(1, 0), b3, voffB);
            PG8_BAR; PG8_WAIT_L(0); PG8_MMA(0, 1, At, B1); PG8_BAR;
            PG8_LDA(At, 1, 1); PG8_STAGE(PG8_SA(1, 0), a3, voffA);
            PG8_BAR; PG8_WAIT_L(0); PG8_MMA(1, 0, At, B0); PG8_BAR; PG8_SCHED;
            PG8_STAGE(PG8_SB(1, 1), b3 + hstep, voffB);
            PG8_WAIT_V(6); PG8_BAR; PG8_MMA(1, 1, At, B1); PG8_BAR;
            }
        }
        if constexpr (ALIGN_EPI) { if (wr == 0) PG8_BAR; }
        if constexpr (!Epi::AFTER_DRAIN) { E(acc, cur, wr, wc, fr, fq); S.done(cur); }
        if (!has_next) break;
#pragma unroll
        for (int a = 0; a < 2; ++a)
#pragma unroll
            for (int b = 0; b < 2; ++b)
#pragma unroll
                for (int m = 0; m < 4; ++m)
#pragma unroll
                    for (int n = 0; n < 2; ++n) acc[a][b][m][n] = (f32x4){0.f, 0.f, 0.f, 0.f};
        cur = nxt; cA = nA; cB = nB; ++ui;
        if constexpr (ALIGN_EPI) { if (wr == 1) PG8_BAR; }
    }
    PG8_WAIT_V(0);
    if constexpr (!ALIGN_EPI) { if (wr == 0) PG8_BAR; }
    PG8_BAR;
    if constexpr (Epi::AFTER_DRAIN) { E.fused(acc, cur, wr, wc, fr, fq, lds, wid, lane); S.done(cur); }
#undef PG8_SA
#undef PG8_SB
#undef PG8_STAGE
#undef PG8_LDA
#undef PG8_LDB
#undef PG8_MMA
#undef PG8_WAIT_V
#undef PG8_WAIT_L
#undef PG8_BAR
#undef PG8_SCHED
}
}
namespace att {
#define LAS __attribute__((address_space(3)))
typedef unsigned short bf16_t;
typedef short bf16x8 __attribute__((ext_vector_type(8)));
typedef float f32x16 __attribute__((ext_vector_type(16)));
typedef float f32x4 __attribute__((ext_vector_type(4)));
typedef unsigned u32x4 __attribute__((ext_vector_type(4)));
typedef unsigned u32x2 __attribute__((ext_vector_type(2)));
typedef float f32x2_t __attribute__((ext_vector_type(2))); typedef __bf16 bf16x2_t __attribute__((ext_vector_type(2)));
__device__ __forceinline__ unsigned cvtpk(float lo, float hi) { f32x2_t v = {lo, hi}; bf16x2_t b = __builtin_convertvector(v, bf16x2_t); return __builtin_bit_cast(unsigned, b); }
constexpr int KP = 144;
constexpr int TB = 64 * KP;
constexpr int OFF_K = 0, OFF_V = 2 * TB, OFF_LUT = 4 * TB, ATT_LDS = 4 * TB + 4 * 452 * 4;
constexpr int PITCH_P = 1280, PITCH_VT = 65536, PITCH_O = 1024;

template <int WIN>
__device__ __forceinline__ void attn_unit(LAS unsigned char* lds, const bf16_t* __restrict__ PROJ, const bf16_t* __restrict__ VT, bf16_t* __restrict__ AO,
                                          int rowbase, int S, int hq, int q0, const float* __restrict__ lut_g, float sink2  ) {
    int tid_ = threadIdx.x; asm volatile("" : "+v"(tid_));
    const int tid = tid_, lane = tid & 63, r32 = lane & 31, hi = lane >> 5; const int wid = __builtin_amdgcn_readfirstlane(tid >> 6);
    const int kvh = hq >> 2;
    const int qcol = WIN ? hq * 64 : 512 + hq * 64;
    const int kcol = WIN ? 1024 + kvh * 64 : 1152 + kvh * 64;
    const int vrow0 = WIN ? kvh * 64 : 128 + kvh * 64;
    const int ocol = WIN ? hq * 64 : 512 + hq * 64;
    int kt0 = 0, kt1 = S >> 6;
    if (WIN) { const int lo = q0 - 128, hi_ = q0 + 256 + 128; kt0 = (lo < 0 ? 0 : lo) >> 6; kt1 = (hi_ > S ? S : hi_) >> 6; }
    const int krow = tid >> 3, kch = tid & 7;
    const bf16_t* ksrc = PROJ + (size_t)(rowbase + krow) * PITCH_P + kcol + kch * 8;
    const bf16_t* vsrc = VT + ((size_t)(rowbase >> 6) * 256 + vrow0 + krow) * 64 + kch * 8;
    const int kdst = OFF_K + krow * KP + kch * 16;
    const int vdst = OFF_V + krow * KP + (kch >> 1) * 32 + (kch & 1) * 8;
    LAS float* lut = (LAS float*)(lds + OFF_LUT);
    if (WIN) { if (tid < 257) lut[tid] = lut_g[tid]; }
    const int qw = q0 + wid * 32;
    const bf16_t* qp = PROJ + (size_t)(rowbase + qw + r32) * PITCH_P + qcol + hi * 8;
    bf16x8 qf[4];
#pragma unroll
    for (int ds = 0; ds < 4; ++ds) qf[ds] = *(const bf16x8*)(qp + ds * 16);
    u32x4 kreg = *(const u32x4*)(ksrc + (size_t)kt0 * 64 * PITCH_P);
    u32x4 vreg = *(const u32x4*)(vsrc + (size_t)kt0 * 16384);
    *(LAS u32x4*)(lds + kdst) = kreg;
    *(LAS u32x2*)(lds + vdst) = (u32x2){vreg.x, vreg.y}; *(LAS u32x2*)(lds + vdst + 16) = (u32x2){vreg.z, vreg.w};
    if (kt0 + 1 < kt1) { kreg = *(const u32x4*)(ksrc + (size_t)(kt0 + 1) * 64 * PITCH_P); vreg = *(const u32x4*)(vsrc + (size_t)(kt0 + 1) * 16384); }
    float m = WIN ? sink2 : 0.f, l = WIN ? 0.5f : 0.f;
    f32x16 negb; { const float nb_ = WIN ? 0.f : -sink2;
#pragma unroll
      for (int r = 0; r < 16; ++r) negb[r] = nb_; }
    f32x16 o0 = {}, o1 = {};
    __syncthreads();
    for (int t = kt0; t < kt1; ++t) {
        const int cur = (t - kt0) & 1;
        if (t + 1 < kt1) {
            const int nb = (cur ^ 1) * TB;
            *(LAS u32x4*)(lds + nb + kdst) = kreg;
            *(LAS u32x2*)(lds + nb + vdst) = (u32x2){vreg.x, vreg.y}; *(LAS u32x2*)(lds + nb + vdst + 16) = (u32x2){vreg.z, vreg.w};
            if (t + 2 < kt1) { kreg = *(const u32x4*)(ksrc + (size_t)(t + 2) * 64 * PITCH_P); vreg = *(const u32x4*)(vsrc + (size_t)(t + 2) * 16384); }
        }
        const int k0 = t * 64;
        bool active = true;
        if (WIN) active = (k0 + 63 >= qw - 128) && (k0 <= qw + 31 + 128);
        if (active) {
            const LAS unsigned char* kb = lds + OFF_K + cur * TB + r32 * KP + hi * 16;
            f32x16 sA = negb, sB = negb;
#pragma unroll
            for (int ds = 0; ds < 4; ++ds) {
                const bf16x8 ka = *(const LAS bf16x8*)(kb + ds * 32);
                const bf16x8 kb2 = *(const LAS bf16x8*)(kb + 32 * KP + ds * 32);
                sA = __builtin_amdgcn_mfma_f32_32x32x16_bf16(ka, qf[ds], sA, 0, 0, 0);
                sB = __builtin_amdgcn_mfma_f32_32x32x16_bf16(kb2, qf[ds], sB, 0, 0, 0);
            }
            if (WIN) {
                const int qpos = qw + r32;
#pragma unroll
                for (int r = 0; r < 16; ++r) {
                    const int key = k0 + (r & 3) + 8 * (r >> 2) + 4 * hi;
                    int relA = key - qpos + 128, relB = relA + 32;
                    const bool vA = (relA >= 0) && (relA <= 256), vB = (relB >= 0) && (relB <= 256);
                    relA = relA < 0 ? 0 : (relA > 256 ? 256 : relA); relB = relB < 0 ? 0 : (relB > 256 ? 256 : relB);
                    sA[r] = vA ? sA[r] + lut[relA] : -1e30f; sB[r] = vB ? sB[r] + lut[relB] : -1e30f;
                }
            }
            if (WIN) {
            float mx = fmaxf(sA[0], sB[0]);
#pragma unroll
            for (int r = 1; r < 16; ++r) mx = fmaxf(mx, fmaxf(sA[r], sB[r]));
            mx = fmaxf(mx, __shfl_xor(mx, 32));
            const float mn = fmaxf(m, mx);
            const float alpha = __builtin_amdgcn_exp2f(m - mn);
            m = mn;
            float ps = 0.f;
#pragma unroll
            for (int r = 0; r < 16; ++r) { sA[r] = __builtin_amdgcn_exp2f(sA[r] - mn); sB[r] = __builtin_amdgcn_exp2f(sB[r] - mn); ps += sA[r] + sB[r]; }
            l = l * alpha + ps;
#pragma unroll
            for (int r = 0; r < 16; ++r) { o0[r] *= alpha; o1[r] *= alpha; }
            } else {
                float ps = 0.f;
#pragma unroll
                for (int r = 0; r < 16; ++r) { sA[r] = __builtin_amdgcn_exp2f(sA[r]); sB[r] = __builtin_amdgcn_exp2f(sB[r]); ps += sA[r] + sB[r]; }
                l += ps;
            }
            bf16x8 pk[4];
            { u32x4 w;
              w.x = cvtpk(sA[0], sA[1]); w.y = cvtpk(sA[2], sA[3]); w.z = cvtpk(sA[4], sA[5]); w.w = cvtpk(sA[6], sA[7]); pk[0] = __builtin_bit_cast(bf16x8, w);
              w.x = cvtpk(sA[8], sA[9]); w.y = cvtpk(sA[10], sA[11]); w.z = cvtpk(sA[12], sA[13]); w.w = cvtpk(sA[14], sA[15]); pk[1] = __builtin_bit_cast(bf16x8, w);
              w.x = cvtpk(sB[0], sB[1]); w.y = cvtpk(sB[2], sB[3]); w.z = cvtpk(sB[4], sB[5]); w.w = cvtpk(sB[6], sB[7]); pk[2] = __builtin_bit_cast(bf16x8, w);
              w.x = cvtpk(sB[8], sB[9]); w.y = cvtpk(sB[10], sB[11]); w.z = cvtpk(sB[12], sB[13]); w.w = cvtpk(sB[14], sB[15]); pk[3] = __builtin_bit_cast(bf16x8, w); }
            const LAS unsigned char* vb = lds + OFF_V + cur * TB + r32 * KP + hi * 16;
#pragma unroll
            for (int s = 0; s < 4; ++s) {
                const bf16x8 va = *(const LAS bf16x8*)(vb + s * 32);
                const bf16x8 vb2 = *(const LAS bf16x8*)(vb + 32 * KP + s * 32);
                o0 = __builtin_amdgcn_mfma_f32_32x32x16_bf16(va, pk[s], o0, 0, 0, 0);
                o1 = __builtin_amdgcn_mfma_f32_32x32x16_bf16(vb2, pk[s], o1, 0, 0, 0);
            }
        }
        asm volatile("s_waitcnt lgkmcnt(0)\n\ts_barrier" ::: "memory");
    }
    const float lt = l + __shfl_xor(l, 32);
    const float inv = 1.0f / lt;
    bf16_t* op = AO + (size_t)(rowbase + qw + r32) * PITCH_O + ocol + 4 * hi;
#pragma unroll
    for (int g4 = 0; g4 < 4; ++g4) {
        u32x2 w0, w1;
        w0.x = cvtpk(o0[4 * g4] * inv, o0[4 * g4 + 1] * inv); w0.y = cvtpk(o0[4 * g4 + 2] * inv, o0[4 * g4 + 3] * inv);
        w1.x = cvtpk(o1[4 * g4] * inv, o1[4 * g4 + 1] * inv); w1.y = cvtpk(o1[4 * g4 + 2] * inv, o1[4 * g4 + 3] * inv);
        *(u32x2*)(op + 8 * g4) = w0; *(u32x2*)(op + 32 + 8 * g4) = w1;
    }
}

#define ATT_BAR() asm volatile("s_waitcnt lgkmcnt(0)\n\ts_barrier" ::: "memory")
__device__ __forceinline__ void attn_global(LAS unsigned char* lds, const bf16_t* __restrict__ PROJ, const bf16_t* __restrict__ VT, bf16_t* __restrict__ AO,
                                            int rowbase, int S, int hq, int q0, float bound2) {
    int tid_ = threadIdx.x; asm volatile("" : "+v"(tid_));
    const int tid = tid_, lane = tid & 63, r32 = lane & 31, hi = lane >> 5; const int wid = __builtin_amdgcn_readfirstlane(tid >> 6);
    const int kvh = hq >> 2, qcol = 512 + hq * 64, kcol = 1152 + kvh * 64, vrow0 = 128 + kvh * 64, ocol = 512 + hq * 64;
    const int T = S >> 6;
    const int krow = tid >> 3, kch = tid & 7;
    const bf16_t* ksrc = PROJ + (size_t)(rowbase + krow) * PITCH_P + kcol + kch * 8;
    const bf16_t* vsrc = VT + ((size_t)(rowbase >> 6) * 256 + vrow0 + krow) * 64 + kch * 8;
    constexpr int RK = 0, RV = 4 * TB;
    const int kdst = RK + krow * KP + kch * 16;
    const int vdst = RV + krow * KP + (kch >> 1) * 32 + (kch & 1) * 8;
    const int qw = q0 + wid * 32;
    const bf16_t* qp = PROJ + (size_t)(rowbase + qw + r32) * PITCH_P + qcol + hi * 8;
    bf16x8 qf[4];
#pragma unroll
    for (int ds = 0; ds < 4; ++ds) qf[ds] = *(const bf16x8*)(qp + ds * 16);
#define LDK(t) (*(const u32x4*)(ksrc + (size_t)(t) * 64 * PITCH_P))
#define LDV(t) (*(const u32x4*)(vsrc + (size_t)(t) * 16384))
#define STK(slot, reg) (*(LAS u32x4*)(lds + (slot) * TB + kdst) = (reg))
#define STV(slot, reg) do { *(LAS u32x2*)(lds + (slot) * TB + vdst) = (u32x2){(reg).x, (reg).y}; *(LAS u32x2*)(lds + (slot) * TB + vdst + 16) = (u32x2){(reg).z, (reg).w}; } while (0)
    u32x4 kra, krb, vra, vrb;
    kra = LDK(0); krb = LDK(1); vra = LDV(0); vrb = LDV(1);
    STK(0, kra); STK(1, krb); STV(0, vra); STV(1, vrb);
    kra = LDK(2); STK(2, kra);
    kra = LDK(3); krb = LDK(4); vra = LDV(2); vrb = LDV(3);
    const f32x16 zero16 = {};
    f32x16 lacc = {};
    const bf16x8 ones8 = {0x3F80, 0x3F80, 0x3F80, 0x3F80, 0x3F80, 0x3F80, 0x3F80, 0x3F80};
    f32x16 o0 = {}, o1 = {}, sA, sB, nA, nB;
    const LAS unsigned char* kfb = lds + RK + r32 * KP + hi * 16;
    const LAS unsigned char* vfb = lds + RV + r32 * KP + hi * 16;
#define QK_TILE(SA, SB, slot) do { _Pragma("unroll") for (int ds = 0; ds < 4; ++ds) { \
        const bf16x8 ka_ = *(const LAS bf16x8*)(kfb + (slot) * TB + ds * 32), kb_ = *(const LAS bf16x8*)(kfb + (slot) * TB + 32 * KP + ds * 32); \
        SA = __builtin_amdgcn_mfma_f32_32x32x16_bf16(ka_, qf[ds], ds == 0 ? zero16 : SA, 0, 0, 0); \
        SB = __builtin_amdgcn_mfma_f32_32x32x16_bf16(kb_, qf[ds], ds == 0 ? zero16 : SB, 0, 0, 0); } } while (0)
    ATT_BAR();
    QK_TILE(sA, sB, 0);
    ATT_BAR();
#define ATT_HALF(SA, SB, NA, NB, ks, vs, DOQK) do { \
        if (DOQK) QK_TILE(NA, NB, ks); \
        _Pragma("unroll") for (int r = 0; r < 16; ++r) { SA[r] = __builtin_amdgcn_exp2f(SA[r]); SB[r] = __builtin_amdgcn_exp2f(SB[r]); } \
        bf16x8 pk_[4]; { u32x4 w_; \
          w_.x = cvtpk(SA[0], SA[1]); w_.y = cvtpk(SA[2], SA[3]); w_.z = cvtpk(SA[4], SA[5]); w_.w = cvtpk(SA[6], SA[7]); pk_[0] = __builtin_bit_cast(bf16x8, w_); \
          w_.x = cvtpk(SA[8], SA[9]); w_.y = cvtpk(SA[10], SA[11]); w_.z = cvtpk(SA[12], SA[13]); w_.w = cvtpk(SA[14], SA[15]); pk_[1] = __builtin_bit_cast(bf16x8, w_); \
          w_.x = cvtpk(SB[0], SB[1]); w_.y = cvtpk(SB[2], SB[3]); w_.z = cvtpk(SB[4], SB[5]); w_.w = cvtpk(SB[6], SB[7]); pk_[2] = __builtin_bit_cast(bf16x8, w_); \
          w_.x = cvtpk(SB[8], SB[9]); w_.y = cvtpk(SB[10], SB[11]); w_.z = cvtpk(SB[12], SB[13]); w_.w = cvtpk(SB[14], SB[15]); pk_[3] = __builtin_bit_cast(bf16x8, w_); } \
        _Pragma("unroll") for (int s = 0; s < 4; ++s) { \
            const bf16x8 va_ = *(const LAS bf16x8*)(vfb + (vs) * TB + s * 32), vb_ = *(const LAS bf16x8*)(vfb + (vs) * TB + 32 * KP + s * 32); \
            o0 = __builtin_amdgcn_mfma_f32_32x32x16_bf16(va_, pk_[s], o0, 0, 0, 0); \
            o1 = __builtin_amdgcn_mfma_f32_32x32x16_bf16(vb_, pk_[s], o1, 0, 0, 0); \
            lacc = __builtin_amdgcn_mfma_f32_32x32x16_bf16(ones8, pk_[s], lacc, 0, 0, 0); } } while (0)
#define ATT_DSTEP(t, p, FULL) do { \
        if (FULL || (t) + 3 < T) STK(((p) + 3) & 3, kra); \
        if (FULL || (t) + 4 < T) STK((p), krb); \
        if (FULL || (t) + 2 < T) STV(((p) + 2) & 3, vra); \
        if (FULL || (t) + 3 < T) STV(((p) + 3) & 3, vrb); \
        if (FULL || (t) + 5 < T) kra = LDK((t) + 5); \
        if (FULL || (t) + 6 < T) krb = LDK((t) + 6); \
        if (FULL || (t) + 4 < T) vra = LDV((t) + 4); \
        if (FULL || (t) + 5 < T) vrb = LDV((t) + 5); \
        ATT_HALF(sA, sB, nA, nB, ((p) + 1) & 3, (p), (FULL || (t) + 1 < T)); \
        ATT_HALF(nA, nB, sA, sB, ((p) + 2) & 3, ((p) + 1) & 3, (FULL || (t) + 2 < T)); \
        ATT_BAR(); } while (0)
    int t = 0;
#pragma unroll 1
    for (; t + 10 < T; t += 4) { ATT_DSTEP(t, 0, true); ATT_DSTEP(t + 2, 2, true); }
#pragma unroll 1
    for (; t < T; t += 4) { ATT_DSTEP(t, 0, false); ATT_DSTEP(t + 2, 2, false); }
#undef ATT_DSTEP
#undef ATT_HALF
#undef QK_TILE
#undef LDK
#undef LDV
#undef STK
#undef STV
    const float inv = 1.0f / lacc[0];
    bf16_t* op = AO + (size_t)(rowbase + qw + r32) * PITCH_O + ocol + 4 * hi;
#pragma unroll
    for (int g4 = 0; g4 < 4; ++g4) {
        u32x2 w0, w1;
        w0.x = cvtpk(o0[4 * g4] * inv, o0[4 * g4 + 1] * inv); w0.y = cvtpk(o0[4 * g4 + 2] * inv, o0[4 * g4 + 3] * inv);
        w1.x = cvtpk(o1[4 * g4] * inv, o1[4 * g4 + 1] * inv); w1.y = cvtpk(o1[4 * g4 + 2] * inv, o1[4 * g4 + 3] * inv);
        *(u32x2*)(op + 8 * g4) = w0; *(u32x2*)(op + 32 + 8 * g4) = w1;
    }
}

__device__ __forceinline__ void attn_win(LAS unsigned char* lds, const bf16_t* __restrict__ PROJ, const bf16_t* __restrict__ VT, bf16_t* __restrict__ AO,
                                         int rowbase, int S, int kvh, int q0, const float* __restrict__ lut_g  , const float* __restrict__ sinkp  ) {
    int tid_ = threadIdx.x; asm volatile("" : "+v"(tid_));
    const int tid = tid_, lane = tid & 63, r32 = lane & 31, hi = lane >> 5; const int wid = __builtin_amdgcn_readfirstlane(tid >> 6);
    const int hq = kvh * 4 + (wid >> 1);
    const int qcol = hq * 64, kcol = 1024 + kvh * 64, vrow0 = kvh * 64, ocol = hq * 64;
    const int lo = q0 - 128, hi_ = q0 + 64 + 128;
    const int kt0 = (lo < 0 ? 0 : lo) >> 6, kt1 = (hi_ > S ? S : hi_) >> 6;
    const int krow = tid >> 3, kch = tid & 7;
    const bf16_t* ksrc = PROJ + (size_t)(rowbase + krow) * PITCH_P + kcol + kch * 8;
    const bf16_t* vsrc = VT + ((size_t)(rowbase >> 6) * 256 + vrow0 + krow) * 64 + kch * 8;
    const int kdst = OFF_K + krow * KP + kch * 16;
    const int vdst = OFF_V + krow * KP + (kch >> 1) * 32 + (kch & 1) * 8;
    LAS float* lut4 = (LAS float*)(lds + OFF_LUT);
    for (int i = tid; i < 4 * 452; i += 512) lut4[i] = lut_g[kvh * 4 * 452 + i];
    const LAS float* lut = lut4 + (wid >> 1) * 452;
    const float sink2 = sinkp[hq] * LOG2E_F;
    const int qw = q0 + (wid & 1) * 32;
    const bf16_t* qp = PROJ + (size_t)(rowbase + qw + r32) * PITCH_P + qcol + hi * 8;
    bf16x8 qf[4];
#pragma unroll
    for (int ds = 0; ds < 4; ++ds) qf[ds] = *(const bf16x8*)(qp + ds * 16);
    u32x4 kreg = *(const u32x4*)(ksrc + (size_t)kt0 * 64 * PITCH_P);
    u32x4 vreg = *(const u32x4*)(vsrc + (size_t)kt0 * 16384);
    *(LAS u32x4*)(lds + kdst) = kreg;
    *(LAS u32x2*)(lds + vdst) = (u32x2){vreg.x, vreg.y}; *(LAS u32x2*)(lds + vdst + 16) = (u32x2){vreg.z, vreg.w};
    if (kt0 + 1 < kt1) { kreg = *(const u32x4*)(ksrc + (size_t)(kt0 + 1) * 64 * PITCH_P); vreg = *(const u32x4*)(vsrc + (size_t)(kt0 + 1) * 16384); }
    float m = sink2, l = 0.5f;
    f32x16 o0 = {}, o1 = {};
    asm volatile("s_waitcnt lgkmcnt(0)\n\ts_barrier" ::: "memory");
    for (int t = kt0; t < kt1; ++t) {
        const int cur = (t - kt0) & 1;
        if (t + 1 < kt1) {
            const int nb = (cur ^ 1) * TB;
            *(LAS u32x4*)(lds + nb + kdst) = kreg;
            *(LAS u32x2*)(lds + nb + vdst) = (u32x2){vreg.x, vreg.y}; *(LAS u32x2*)(lds + nb + vdst + 16) = (u32x2){vreg.z, vreg.w};
            if (t + 2 < kt1) { kreg = *(const u32x4*)(ksrc + (size_t)(t + 2) * 64 * PITCH_P); vreg = *(const u32x4*)(vsrc + (size_t)(t + 2) * 16384); }
        }
        const int k0 = t * 64;
        if ((k0 + 63 >= qw - 128) && (k0 <= qw + 31 + 128)) {
            const LAS unsigned char* kb = lds + OFF_K + cur * TB + r32 * KP + hi * 16;
            f32x16 sA = {}, sB = {};
#pragma unroll
            for (int ds = 0; ds < 4; ++ds) {
                const bf16x8 ka = *(const LAS bf16x8*)(kb + ds * 32);
                const bf16x8 kb2 = *(const LAS bf16x8*)(kb + 32 * KP + ds * 32);
                sA = __builtin_amdgcn_mfma_f32_32x32x16_bf16(ka, qf[ds], sA, 0, 0, 0);
                sB = __builtin_amdgcn_mfma_f32_32x32x16_bf16(kb2, qf[ds], sB, 0, 0, 0);
            }
            { const LAS float* lp = lut + (k0 - (qw + r32) + 224 + 4 * hi);
#pragma unroll
              for (int r = 0; r < 16; ++r) { sA[r] += lp[(r & 3) + 8 * (r >> 2)]; sB[r] += lp[32 + (r & 3) + 8 * (r >> 2)]; } }
            float mx = fmaxf(sA[0], sB[0]);
#pragma unroll
            for (int r = 1; r < 16; ++r) mx = fmaxf(mx, fmaxf(sA[r], sB[r]));
            mx = fmaxf(mx, __shfl_xor(mx, 32));
            const float mn = fmaxf(m, mx);
            const float alpha = __builtin_amdgcn_exp2f(m - mn);
            m = mn;
            float ps = 0.f;
#pragma unroll
            for (int r = 0; r < 16; ++r) { sA[r] = __builtin_amdgcn_exp2f(sA[r] - mn); sB[r] = __builtin_amdgcn_exp2f(sB[r] - mn); ps += sA[r] + sB[r]; }
            l = l * alpha + ps;
#pragma unroll
            for (int r = 0; r < 16; ++r) { o0[r] *= alpha; o1[r] *= alpha; }
            bf16x8 pk[4];
            { u32x4 w;
              w.x = cvtpk(sA[0], sA[1]); w.y = cvtpk(sA[2], sA[3]); w.z = cvtpk(sA[4], sA[5]); w.w = cvtpk(sA[6], sA[7]); pk[0] = __builtin_bit_cast(bf16x8, w);
              w.x = cvtpk(sA[8], sA[9]); w.y = cvtpk(sA[10], sA[11]); w.z = cvtpk(sA[12], sA[13]); w.w = cvtpk(sA[14], sA[15]); pk[1] = __builtin_bit_cast(bf16x8, w);
              w.x = cvtpk(sB[0], sB[1]); w.y = cvtpk(sB[2], sB[3]); w.z = cvtpk(sB[4], sB[5]); w.w = cvtpk(sB[6], sB[7]); pk[2] = __builtin_bit_cast(bf16x8, w);
              w.x = cvtpk(sB[8], sB[9]); w.y = cvtpk(sB[10], sB[11]); w.z = cvtpk(sB[12], sB[13]); w.w = cvtpk(sB[14], sB[15]); pk[3] = __builtin_bit_cast(bf16x8, w); }
            const LAS unsigned char* vb = lds + OFF_V + cur * TB + r32 * KP + hi * 16;
#pragma unroll
            for (int s = 0; s < 4; ++s) {
                const bf16x8 va = *(const LAS bf16x8*)(vb + s * 32);
                const bf16x8 vb2 = *(const LAS bf16x8*)(vb + 32 * KP + s * 32);
                o0 = __builtin_amdgcn_mfma_f32_32x32x16_bf16(va, pk[s], o0, 0, 0, 0);
                o1 = __builtin_amdgcn_mfma_f32_32x32x16_bf16(vb2, pk[s], o1, 0, 0, 0);
            }
        }
        asm volatile("s_waitcnt lgkmcnt(0)\n\ts_barrier" ::: "memory");
    }
    const float lt = l + __shfl_xor(l, 32);
    const float inv = 1.0f / lt;
    bf16_t* op = AO + (size_t)(rowbase + qw + r32) * PITCH_O + ocol + 4 * hi;
#pragma unroll
    for (int g4 = 0; g4 < 4; ++g4) {
        u32x2 w0, w1;
        w0.x = cvtpk(o0[4 * g4] * inv, o0[4 * g4 + 1] * inv); w0.y = cvtpk(o0[4 * g4 + 2] * inv, o0[4 * g4 + 3] * inv);
        w1.x = cvtpk(o1[4 * g4] * inv, o1[4 * g4 + 1] * inv); w1.y = cvtpk(o1[4 * g4 + 2] * inv, o1[4 * g4 + 3] * inv);
        *(u32x2*)(op + 8 * g4) = w0; *(u32x2*)(op + 32 + 8 * g4) = w1;
    }
}
}

typedef unsigned short bf16;
typedef unsigned v4u __attribute__((ext_vector_type(4)));
typedef unsigned v2u __attribute__((ext_vector_type(2)));
typedef float f32x4 __attribute__((ext_vector_type(4)));
constexpr int NWAVES = 8;
#ifndef DUP_ATT
#define DUP_ATT 1
#endif
#ifndef DUP_FFN1
#define DUP_FFN1 1
#endif
#ifndef DUP_LN
#define DUP_LN 1
#endif
#ifndef DUP_PRO
#define DUP_PRO 1
#endif
#ifndef DUP_P1
#define DUP_P1 1
#endif
#ifndef DUP_OP
#define DUP_OP 1
#endif
#ifndef DUP_DN
#define DUP_DN 1
#endif
constexpr int DM = 1024, DIN = 1536, DFF = 2816, DEPTH = 4, MTOT = 65536, MHALF = 32768, NPROJ = 1280;
constexpr size_t MiB = 1u << 20;
constexpr size_t WS_ROPE = 0;
constexpr size_t WS_LUT = 32768;
constexpr size_t WS_STATS = 256 * 1024;
constexpr size_t WS_W = 1 * MiB;
constexpr size_t W_P = 0, W_V = W_P + (size_t)1280 * 1024, W_O = W_V + (size_t)256 * 1024, W_GU = W_O + (size_t)1024 * 1024, W_D = W_GU + (size_t)5632 * 1024, W_LAYER = W_D + (size_t)1024 * 2816;
constexpr size_t WS_XB = 88 * MiB;
constexpr size_t WS_PROJ = 216 * MiB;
constexpr size_t WS_VT = 376 * MiB;
constexpr size_t WS_H = 216 * MiB;
constexpr size_t WS_MX0 = 408 * MiB;
constexpr size_t WS_END = 472 * MiB;
static_assert(W_LAYER * 2 * 3 >= (size_t)MHALF * DM * 2 && WS_W + W_LAYER * 2 * DEPTH <= WS_XB && WS_H + (size_t)MHALF * DFF * 2 <= WS_END, "ws map");
constexpr int LDS_BYTES = 135168;

constexpr size_t WS_BAR = 65536;
#define XB_TMO      128
#define XB_XCNT(j)  (256  + 64 * (j))
#define XB_XSUB(j)  (1280 + 64 * (j))
#define XB_XGEN(j)  (2304 + 64 * (j))
#define XB_TOP      3328
#define XB_TOPGEN   3392
#define XCD_BAR_WORDS 3456
#define XB_SPIN_CAP (1u << 18)

__device__ __forceinline__ unsigned xb_ld(unsigned* p)              { return __hip_atomic_load(p, __ATOMIC_RELAXED, __HIP_MEMORY_SCOPE_AGENT); }
__device__ __forceinline__ unsigned xb_add(unsigned* p, unsigned v) { return __hip_atomic_fetch_add(p, v, __ATOMIC_RELAXED, __HIP_MEMORY_SCOPE_AGENT); }
__device__ __forceinline__ unsigned xb_xcc_id() { return (unsigned)__builtin_amdgcn_s_getreg((3 << 11) | 20) & 0xFu; }
#define XB_SPIN(cond, bar) do { unsigned _sp = 0; while (cond) { __builtin_amdgcn_s_sleep(1); \
    if ((++_sp & 255u) == 0u) { if (xb_ld(&(bar)[XB_TMO])) break; if (_sp > XB_SPIN_CAP) { atomicAdd(&(bar)[XB_TMO], 1u); break; } } } } while (0)

struct XcdBarrier {
    unsigned* bar; unsigned x;
    volatile LAS unsigned* st;
};

__device__ __forceinline__ XcdBarrier xcd_barrier_post(unsigned* bar, volatile LAS unsigned* st) {
    XcdBarrier b; b.bar = bar; b.x = xb_xcc_id(); b.st = st;
    if (threadIdx.x == 0) (void)xb_add(&bar[XB_XCNT(b.x)], 1u);
    return b;
}
__device__ __forceinline__ void xcd_barrier_complete(unsigned* bar, unsigned x, unsigned& nloc, unsigned& nx) {
    const unsigned G = gridDim.x * gridDim.y * gridDim.z;
    unsigned sum, cnt, mine, sp = 0u;
    for (;;) {
        sum = 0u; cnt = 0u; mine = 0u;
#pragma unroll
        for (unsigned j = 0; j < 16; ++j) { const unsigned c = xb_ld(&bar[XB_XCNT(j)]); sum += c; cnt += (c > 0u) ? 1u : 0u; mine = (j == x) ? c : mine; }
        if (sum == G) break;
        __builtin_amdgcn_s_sleep(1);
        if ((++sp & 255u) == 0u) { if (xb_ld(&bar[XB_TMO])) break; if (sp > XB_SPIN_CAP) { atomicAdd(&bar[XB_TMO], 1u); break; } }
    }
    nloc = mine > 0u ? mine : 1u; nx = cnt > 0u ? cnt : 1u;
}

__device__ __forceinline__ void xcd_barrier(const XcdBarrier& b) {
    asm volatile("s_waitcnt vmcnt(0)" ::: "memory");
    __syncthreads();
    if (threadIdx.x == 0) {
        unsigned* bar = b.bar;
        __builtin_amdgcn_s_waitcnt(0);
        unsigned nloc = b.st[0], nx = b.st[1];
        if (nloc == 0u) { xcd_barrier_complete(bar, b.x, nloc, nx); b.st[0] = nloc; b.st[1] = nx; }
        const unsigned old = xb_add(&bar[XB_XSUB(b.x)], 1u);
        const unsigned gen = old / nloc;
        if (old + 1u == (gen + 1u) * nloc) {
            __builtin_amdgcn_fence(__ATOMIC_RELEASE, "agent");
            asm volatile("s_waitcnt vmcnt(0)" ::: "memory");
            const unsigned og = xb_add(&bar[XB_TOP], 1u);
            const unsigned tg = og / nx;
            if (og + 1u == (tg + 1u) * nx) xb_add(&bar[XB_TOPGEN], 1u);
            else XB_SPIN(xb_ld(&bar[XB_TOPGEN]) == tg, bar);
            __builtin_amdgcn_fence(__ATOMIC_ACQUIRE, "agent");
            xb_add(&bar[XB_XGEN(b.x)], 1u);
            asm volatile("s_waitcnt vmcnt(0)" ::: "memory");
        } else {
            XB_SPIN(xb_ld(&bar[XB_XGEN(b.x)]) == gen, bar);
            __builtin_amdgcn_fence(__ATOMIC_ACQUIRE, "agent");
            asm volatile("s_waitcnt vmcnt(0)" ::: "memory");
        }
    }
    __syncthreads();
}

struct Args { const float* in[15]; float* out; unsigned char* ws; int ph_lo, ph_hi; };

__device__ __forceinline__ unsigned f2bf(float f) { unsigned u = __builtin_bit_cast(unsigned, f); return (u + 0x7fffu + ((u >> 16) & 1u)) >> 16; }
__device__ __forceinline__ unsigned pk2(float lo, float hi) { return f2bf(lo) | (f2bf(hi) << 16); }
typedef _Float16 h16x2 __attribute__((ext_vector_type(2))); typedef _Float16 h16x4 __attribute__((ext_vector_type(4))); typedef float f32x2p __attribute__((ext_vector_type(2)));
__device__ __forceinline__ unsigned pkh(float lo, float hi) { f32x2p v = {lo, hi}; return __builtin_bit_cast(unsigned, __builtin_convertvector(v, h16x2)); }
template <bool H> __device__ __forceinline__ unsigned pk16(float lo, float hi) { return H ? pkh(lo, hi) : pk2(lo, hi); }
__device__ __forceinline__ float wave_sum(float v) {
#pragma unroll
    for (int o = 1; o < 64; o <<= 1) v += __shfl_xor(v, o);
    return v;
}
template <bool H>
__device__ __forceinline__ void transpose_item(const float* __restrict__ W, int ldw, int col0, int k0, bf16* __restrict__ WT, int K, int n0, LAS float* scr, int lane) {
#pragma unroll 8
    for (int i = 0; i < 32; ++i) { const int kk = 2 * i + (lane >> 5); scr[kk * 33 + (lane & 31)] = W[(size_t)(k0 + kk) * ldw + col0 + (lane & 31)]; }
    asm volatile("s_waitcnt lgkmcnt(0)" ::: "memory");
    const int c = lane & 7;
#pragma unroll
    for (int j = 0; j < 4; ++j) { const int n = (lane >> 3) + 8 * j; const LAS float* s = scr + (8 * c) * 33 + n;
        v4u o; o.x = pk16<H>(s[0 * 33], s[1 * 33]); o.y = pk16<H>(s[2 * 33], s[3 * 33]); o.z = pk16<H>(s[4 * 33], s[5 * 33]); o.w = pk16<H>(s[6 * 33], s[7 * 33]);
        *(v4u*)(WT + (size_t)(n0 + n) * K + k0 + 8 * c) = o; }
    asm volatile("s_waitcnt lgkmcnt(0)" ::: "memory");
}

typedef const __attribute__((address_space(4))) Args* CArgsP;
__device__ __forceinline__ void prologue(CArgsP ap_, LAS unsigned char* lds, int gw, int ngw, int wave, int lane) {
    Args a;
#pragma unroll
    for (int i = 0; i < 15; ++i) a.in[i] = ap_->in[i];
    a.out = ap_->out; a.ws = ap_->ws; a.ph_lo = 0; a.ph_hi = 0;
    unsigned char* ws = a.ws;
    LAS float* scr = (LAS float*)(lds + wave * 16384);
    constexpr int I_P = 16 * 40, I_V = 16 * 8, I_O = 16 * 32, I_GU = 16 * 176, I_D = 44 * 32, I_LAYER = I_P + I_V + I_O + I_GU + I_D;
    for (int it = gw; it < I_LAYER * DEPTH; it += ngw) {
        const int l = it / I_LAYER; int r = it % I_LAYER;
        bf16* wl = (bf16*)(ws + WS_W) + (size_t)l * W_LAYER;
        const float* w_in = a.in[3] + (size_t)l * DM * DIN;
        if (r < I_P) { const int kb = r / 40, nb = r % 40, tile = nb >> 3, r8 = nb & 7, bj = r8 >> 2, wc = r8 & 3; int col;
            if (tile < 2) col = (4 * tile + wc) * 64 + 32 * bj;
            else if (tile < 4) col = 768 + (4 * (tile - 2) + wc) * 64 + 32 * bj;
            else if (wc < 2) col = 512 + wc * 64 + 32 * bj;
            else col = 1280 + (wc - 2) * 64 + 32 * bj;
            transpose_item<true>(w_in, DIN, col, kb * 64, wl + W_P, DM, nb * 32, scr, lane); continue; }
        r -= I_P;
        if (r < I_V) { const int kb = r / 8, nb = r % 8; const int col = nb < 4 ? 640 + 32 * nb : 1408 + 32 * (nb - 4);
            transpose_item<true>(w_in, DIN, col, kb * 64, wl + W_V, DM, nb * 32, scr, lane); continue; }
        r -= I_V;
        if (r < I_O) { const int kb = r / 32, nb = r % 32;
            transpose_item<false>(a.in[4] + (size_t)l * DM * DM, DM, nb * 32, kb * 64, wl + W_O, DM, nb * 32, scr, lane); continue; }
        r -= I_O;
        if (r < I_GU) { const int kb = r / 176, nb = r % 176, pn = nb >> 3, r8 = nb & 7;
            const float* src = (r8 < 4 ? a.in[10] : a.in[11]) + (size_t)l * DM * DFF;
            transpose_item<true>(src, DFF, 128 * pn + 32 * (r8 & 3), kb * 64, wl + W_GU, DM, nb * 32, scr, lane); continue; }
        r -= I_GU;
        { const int kb = r / 32, nb = r % 32;
            transpose_item<false>(a.in[12] + (size_t)l * DFF * DM, DM, nb * 32, kb * 64, wl + W_D, DFF, nb * 32, scr, lane); }
    }
    bf16* XB = (bf16*)(ws + WS_XB);
    for (int row = gw; row < MTOT; row += ngw) {
        const float* src = row < MHALF ? a.in[0] + (size_t)row * DM : a.in[1] + (size_t)(row - MHALF) * DM;
        const f32x4* xr = (const f32x4*)src + lane; v2u* ob = (v2u*)(XB + (size_t)row * DM) + lane;
#pragma unroll
        for (int j = 0; j < 4; ++j) { const f32x4 v = xr[64 * j]; v2u w; w.x = pkh(v[0], v[1]); w.y = pkh(v[2], v[3]); ob[64 * j] = w; }
    }
    const int gt = gw * 64 + lane, ngt = ngw * 64;
    float* rope = (float*)(ws + WS_ROPE);
    for (int i = gt; i < 128 * 16; i += ngt) { const int pos = i >> 4, j = i & 15;
        const float inv = powf(10000.0f, -(float)(2 * j) / 32.0f); const float ang = (float)pos * inv;
        rope[2 * i] = cosf(ang); rope[2 * i + 1] = sinf(ang); }
    float* lutg = (float*)(ws + WS_LUT);
    for (int i = gt; i < 8 * 452; i += ngt) { const int h = i / 452, idx = i % 452; float v = -1e30f; const int rel = idx - 224;
        if (rel >= -128 && rel <= 128) { const int n = rel < 0 ? -rel : rel; int bucket = rel > 0 ? 16 : 0;
            int large = 8 + (n >= 12) + (n >= 16) + (n >= 23) + (n >= 32) + (n >= 46) + (n >= 64) + (n >= 91); large = large > 15 ? 15 : large;
            bucket += n < 8 ? n : large; v = a.in[2][bucket * 8 + h] * LOG2E_F; }
        lutg[i] = v; }
}

__device__ __forceinline__ f32x4 bf4(v2u m) { f32x4 f; f[0] = __builtin_bit_cast(float, m.x << 16); f[1] = __builtin_bit_cast(float, m.x & 0xffff0000u); f[2] = __builtin_bit_cast(float, m.y << 16); f[3] = __builtin_bit_cast(float, m.y & 0xffff0000u); return f; }
__device__ __forceinline__ f32x4 h4(v2u m) { const h16x4 h = __builtin_bit_cast(h16x4, m); return __builtin_convertvector(h, f32x4); }
template <bool FINAL>
__device__ __forceinline__ void ln_phase(float* OUT, const bf16* MXlo, const bf16* MXhi, bf16* XB, const float* __restrict__ g, const float* __restrict__ b, int gw, int ngw, int lane) {
    constexpr int R = 4;
    for (int row0 = gw; row0 < MTOT; row0 += R * ngw) {
        f32x4 v[R][4];
#pragma unroll
        for (int r = 0; r < R; ++r) { const int row = row0 + r * ngw; if (row < MTOT) {
            const v2u* xr = (const v2u*)(XB + (size_t)row * DM) + lane; const v2u* mr = (const v2u*)((row < MHALF ? MXlo : MXhi) + (size_t)row * DM) + lane;
#pragma unroll
            for (int j = 0; j < 4; ++j) v[r][j] = h4(xr[64 * j]) * ALPHA_DN + bf4(mr[64 * j]); } }
#pragma unroll
        for (int r = 0; r < R; ++r) { const int row = row0 + r * ngw; if (row < MTOT) {
            f32x4* orow = (f32x4*)(OUT + (size_t)row * DM) + lane; v2u* ob = (v2u*)(XB + (size_t)row * DM) + lane;
            float s = 0.f;
#pragma unroll
            for (int j = 0; j < 4; ++j) s += (v[r][j][0] + v[r][j][1]) + (v[r][j][2] + v[r][j][3]);
            const float mean = wave_sum(s) * (1.f / DM); float s2 = 0.f;
#pragma unroll
            for (int j = 0; j < 4; ++j) { v[r][j] = v[r][j] - mean; s2 += (v[r][j][0] * v[r][j][0] + v[r][j][1] * v[r][j][1]) + (v[r][j][2] * v[r][j][2] + v[r][j][3] * v[r][j][3]); }
            const float rstd = 1.f / sqrtf(wave_sum(s2) * (1.f / DM) + 1e-5f);
#pragma unroll
            for (int j = 0; j < 4; ++j) { const f32x4 y = v[r][j] * rstd * ((const f32x4*)g)[lane + 64 * j] + ((const f32x4*)b)[lane + 64 * j];
                if (FINAL) orow[64 * j] = y; else { v2u w; w.x = pkh(y[0], y[1]); w.y = pkh(y[2], y[3]); ob[64 * j] = w; } } } }
    }
}

typedef const __attribute__((address_space(4))) Args* CArgs;
__device__ __forceinline__ CArgs argp() { CArgs p = (CArgs)__builtin_amdgcn_kernarg_segment_ptr(); asm volatile("" : "+s"(p)); return p; }
struct Ids { int lane, wave, G, bx, vcu, gw, ngw; };
__device__ __forceinline__ Ids ids() { Ids r; int tid_ = threadIdx.x; asm volatile("" : "+v"(tid_)); r.lane = tid_ & 63; r.wave = __builtin_amdgcn_readfirstlane(tid_ >> 6);
    int g_ = gridDim.x, b_ = blockIdx.x; asm volatile("" : "+s"(g_), "+s"(b_)); r.G = g_; r.bx = b_; r.vcu = (g_ % 8 == 0) ? (b_ % 8) * (g_ / 8) + b_ / 8 : b_; r.gw = r.vcu * NWAVES + r.wave; r.ngw = g_ * NWAVES; return r; }

__global__ void __launch_bounds__(NWAVES * 64, 2) mega_fwd(Args a_unused) {
    extern __shared__ __attribute__((aligned(16))) unsigned char lds_raw[];
    LAS unsigned char* lds = (LAS unsigned char*)lds_raw;
    cg::grid_group grid = cg::this_grid();
    volatile LAS unsigned* bst = (volatile LAS unsigned*)(lds + 131072);
    if (threadIdx.x < 2) bst[threadIdx.x] = 0u;
    __syncthreads();
    (void)xcd_barrier_post((unsigned*)(argp()->ws + WS_BAR), bst);
    const int ph_lo = argp()->ph_lo, ph_hi = argp()->ph_hi;
    int ph = 0;
#define PH_ON (ph >= ph_lo && ph < ph_hi)
#define PH_END do { if (ph >= ph_lo && ph + 1 < ph_hi) { if (ph == 0) grid.sync(); else { XcdBarrier xb_; xb_.bar = (unsigned*)(argp()->ws + WS_BAR); xb_.x = xb_xcc_id(); xb_.st = bst; xcd_barrier(xb_); } } ++ph; } while (0)

    if (PH_ON) {
#pragma unroll 1
        for (int rep_ = 0; rep_ < DUP_PRO; ++rep_) { const Ids I = ids(); prologue(argp(), lds, I.gw, I.ngw, I.wave, I.lane); } }
    PH_END;
#pragma unroll 1
    for (int l = 0; l < DEPTH; ++l) {
        if (PH_ON) {
#pragma unroll 1
            for (int rep_ = 0; rep_ < DUP_P1; ++rep_) {
            const Ids I = ids(); CArgs ap = argp(); unsigned char* ws = ap->ws;
            const bf16* wl = (const bf16*)(ws + WS_W) + (size_t)l * W_LAYER; bf16* XB = (bf16*)(ws + WS_XB);
            { pg8::Gemm g{XB, wl + W_P, MTOT, NPROJ, DM}; pg8::StaticOrder S; S.init(MTOT, NPROJ, I.G, I.bx);
              pg8::EpiProj E{(bf16*)(ws + WS_PROJ), ap->in[6] + l * 64, ap->in[7] + l * 64, (const float*)(ws + WS_ROPE)};
              pg8::gemm_phase<pg8::EpiProj, pg8::StaticOrder, true, true, true>(lds, g, S, E); }
            { pg8::Gemm g{wl + W_V, XB, 256, MTOT, DM}; pg8::StaticOrder S; S.init(256, MTOT, I.G, I.bx);
              pg8::EpiVT E{(bf16*)(ws + WS_VT)};
              pg8::gemm_phase<pg8::EpiVT, pg8::StaticOrder, true, true, true>(lds, g, S, E); }
            }
        }
        PH_END;
        if (PH_ON) {
            const Ids I = ids(); CArgs ap = argp(); unsigned char* ws = ap->ws;
            const bf16* PROJ = (const bf16*)(ws + WS_PROJ); const bf16* VT = (const bf16*)(ws + WS_VT); bf16* AO = (bf16*)ap->out;   const float* lutg = (const float*)(ws + WS_LUT);
            const float* sinkp = ap->in[5] + l * 8;
            float gq = fabsf(ap->in[6][l * 64 + I.lane]), gk = fabsf(ap->in[7][l * 64 + I.lane]);
#pragma unroll
            for (int o_ = 1; o_ < 64; o_ <<= 1) { gq = fmaxf(gq, __shfl_xor(gq, o_)); gk = fmaxf(gk, __shfl_xor(gk, o_)); }
            const float bound2 = 64.0f * QSCALE_F * gq * gk * 1.01f;
            if (bound2 <= 100.0f) {
#pragma unroll 1
            for (int rep_ = 0; rep_ < DUP_ATT; ++rep_)
#pragma unroll 1
            for (int u = I.vcu; u < 4096; u += I.G) {
                const int kind = u >> 10, idx = u & 1023; const bool sample = kind & 1, win = kind >= 2;
                const int S = sample ? 8192 : 4096, nqb = S >> 8, per = 4 * nqb;
                const int bk = idx / per, rem = idx % per, b = bk >> 1, kvh = bk & 1, hq = kvh * 4 + rem / nqb, qb = rem % nqb;
                const int rowbase = (sample ? MHALF : 0) + b * S;
                if (win) att::attn_win(lds, PROJ, VT, AO, rowbase, S, kvh, rem * 64, lutg, sinkp);
                else att::attn_global(lds, PROJ, VT, AO, rowbase, S, hq, qb * 256, bound2);
            }
            } else {
#pragma unroll 1
            for (int u = I.vcu; u < 4096; u += I.G) {
                const int kind = u >> 10, idx = u & 1023; const bool sample = kind & 1, win = kind >= 2;
                const int S = sample ? 8192 : 4096, nqb = S >> 8, per = 4 * nqb;
                const int bk = idx / per, rem = idx % per, b = bk >> 1, kvh = bk & 1, hq = kvh * 4 + rem / nqb, qb = rem % nqb;
                const int rowbase = (sample ? MHALF : 0) + b * S;
                if (win) att::attn_win(lds, PROJ, VT, AO, rowbase, S, kvh, rem * 64, lutg, sinkp);
                else att::attn_unit<0>(lds, PROJ, VT, AO, rowbase, S, hq, qb * 256, lutg, bound2);
            }
            }
        }
        PH_END;
        if (PH_ON) {
            const Ids I = ids(); CArgs ap = argp(); unsigned char* ws = ap->ws;
            const bf16* wl = (const bf16*)(ws + WS_W) + (size_t)l * W_LAYER;
            pg8::Gemm g{(const bf16*)ap->out, wl + W_O, MTOT, DM, DM}; pg8::StaticOrder S; S.init(MTOT, DM, I.G, I.bx);
            pg8::EpiBf16 E{(bf16*)(ws + WS_PROJ), DM};
#pragma unroll 1
            for (int rep_ = 0; rep_ < DUP_OP; ++rep_)
            pg8::gemm_phase<pg8::EpiBf16, pg8::StaticOrder, true, true>(lds, g, S, E);
        }
        PH_END;
        if (PH_ON) { const Ids I = ids(); CArgs ap = argp(); const bf16* mx = (const bf16*)(ap->ws + WS_PROJ);
            ln_phase<false>(ap->out, mx, mx, (bf16*)(ap->ws + WS_XB), ap->in[8] + l * DM, ap->in[9] + l * DM, I.gw, I.ngw, I.lane); }
        PH_END;
#pragma unroll 1
        for (int half = 0; half < 2; ++half) {
            if (PH_ON) {
                const Ids I = ids(); CArgs ap = argp(); unsigned char* ws = ap->ws;
                const bf16* wl = (const bf16*)(ws + WS_W) + (size_t)l * W_LAYER;
                pg8::Gemm g{(const bf16*)(ws + WS_XB) + (size_t)half * MHALF * DM, wl + W_GU, MHALF, 2 * DFF, DM}; pg8::StaticOrder S; S.init(MHALF, 2 * DFF, I.G, I.bx);
                pg8::EpiSwiGLU E{(bf16*)(ws + WS_H), DFF};
#pragma unroll 1
                for (int rep_ = 0; rep_ < DUP_FFN1; ++rep_)
                pg8::gemm_phase<pg8::EpiSwiGLU, pg8::StaticOrder, true, true, true>(lds, g, S, E);
            }
            PH_END;
            if (PH_ON) {
                const Ids I = ids(); CArgs ap = argp(); unsigned char* ws = ap->ws;
                const bf16* wl = (const bf16*)(ws + WS_W) + (size_t)l * W_LAYER;
                pg8::Gemm g{(const bf16*)(ws + WS_H), wl + W_D, MHALF, DM, DFF}; pg8::StaticOrder S; S.init(MHALF, DM, I.G, I.bx);
                pg8::EpiBf16 E{half == 0 ? (bf16*)(ws + WS_MX0) : (l < DEPTH - 1 ? (bf16*)((char*)ap->out + 128 * MiB) : (bf16*)(ws + WS_W)), DM};
#pragma unroll 1
                for (int rep_ = 0; rep_ < DUP_DN; ++rep_)
                pg8::gemm_phase<pg8::EpiBf16, pg8::StaticOrder, true, true>(lds, g, S, E);
            }
            PH_END;
        }
        if (PH_ON) { const Ids I = ids(); CArgs ap = argp(); const bf16* mlo = (const bf16*)(ap->ws + WS_MX0); bf16* xb = (bf16*)(ap->ws + WS_XB);
            const bf16* mhi = (l < DEPTH - 1 ? (const bf16*)((const char*)ap->out + 128 * MiB) : (const bf16*)(ap->ws + WS_W)) - (size_t)MHALF * DM;
            if (l == DEPTH - 1) ln_phase<true>(ap->out, mlo, mhi, xb, ap->in[13] + l * DM, ap->in[14] + l * DM, I.gw, I.ngw, I.lane);
            else ln_phase<false>(ap->out, mlo, mhi, xb, ap->in[13] + l * DM, ap->in[14] + l * DM, I.gw, I.ngw, I.lane); }
        PH_END;
    }
}
constexpr int N_PHASES = 1 + DEPTH * 9;

#ifndef MK_MULTI
#define MK_MULTI 0
#endif
extern "C" void kernel_launch(void* const* d_in, const int* in_sizes, int n_in, void* d_out, int out_size, void* d_ws, size_t ws_size, hipStream_t stream) {
    static int grid = 0;
    if (grid == 0) {
        if (n_in != 15 || out_size != MTOT * DM || ws_size < WS_END) { fprintf(stderr, "kernel_launch: unexpected shapes: n_in %d out %d ws %zu (need %zu)\n", n_in, out_size, ws_size, (size_t)WS_END); grid = -1; return; }
        int dev = 0, cus = 0, per_cu = 0;
        hipGetDevice(&dev); hipDeviceGetAttribute(&cus, hipDeviceAttributeMultiprocessorCount, dev);
        if (hipFuncSetAttribute((const void*)mega_fwd, hipFuncAttributeMaxDynamicSharedMemorySize, LDS_BYTES) != hipSuccess) { fprintf(stderr, "kernel_launch: hipFuncSetAttribute failed\n"); grid = -1; return; }
        if (hipOccupancyMaxActiveBlocksPerMultiprocessor(&per_cu, (const void*)mega_fwd, NWAVES * 64, LDS_BYTES) != hipSuccess || per_cu < 1) { fprintf(stderr, "kernel_launch: occupancy query gave %d\n", per_cu); per_cu = 1; }
        (void)hipGetLastError();
        grid = cus * per_cu;
        fprintf(stderr, "kernel_launch: grid %d (cus %d x %d), ws %zu\n", grid, cus, per_cu, ws_size);
    }
    if (grid < 0) return;
    if (hipMemsetAsync((char*)d_ws + WS_BAR, 0, 16384, stream) != hipSuccess) { fprintf(stderr, "kernel_launch: memset failed\n"); return; }
    Args a{};
    for (int i = 0; i < 15; ++i) a.in[i] = (const float*)d_in[i];
    a.out = (float*)d_out; a.ws = (unsigned char*)d_ws;
#if MK_MULTI
    for (int p = 0; p < N_PHASES; ++p) { a.ph_lo = p; a.ph_hi = p + 1; hipLaunchKernelGGL(mega_fwd, dim3(grid), dim3(NWAVES * 64), LDS_BYTES, stream, a); }
#else
    a.ph_lo = 0; a.ph_hi = N_PHASES;
    void* args[] = {&a};
    hipError_t e = hipLaunchCooperativeKernel((const void*)mega_fwd, dim3(grid), dim3(NWAVES * 64), args, LDS_BYTES, stream);
    if (e != hipSuccess) fprintf(stderr, "cooperative launch failed: %s (grid %d)\n", hipGetErrorString(e), grid);
#endif
}
```

```cpp
#include <hip/hip_runtime.h>
#include <hip/hip_cooperative_groups.h>
#include <cstdio>
#include <cstdint>
namespace cg = cooperative_groups;
#define ALPHA_DN 1.681792830507429f
#define LOG2E_F 1.4426950408889634f
#define QSCALE_F (0.125f * 1.4426950408889634f)
namespace pg8 {
#define PG8_LAS __attribute__((address_space(3)))
typedef unsigned short bf16_t;
typedef short bf16x8 __attribute__((ext_vector_type(8)));
typedef float f32x4 __attribute__((ext_vector_type(4)));
typedef unsigned u32x4 __attribute__((ext_vector_type(4)));
constexpr int BM = 256, BK = 64, HALF = 128, HTB = HALF * BK * 2  , STAGE_BYTES = 8 * HTB, NXCD = 8, WGM = 8;

__host__ __device__ __forceinline__ int lds_byte(int r, int c) { const int st = (r >> 4) * 2 + (c >> 5), rr = r & 15, cc = c & 31, ob = rr * 64 + cc * 2; return st * 1024 + (ob ^ (((ob >> 9) & 1) << 5)); }
__host__ __device__ __forceinline__ void stage_rc(int b, int& R, int& C) { const int st = b / 1024, sb = b % 1024, swz = sb ^ (((sb >> 9) & 1) << 5); R = (st >> 1) * 16 + swz / 64; C = (st & 1) * 32 + (swz % 64) / 2; }
__host__ __device__ __forceinline__ int perm32(int rho) { const int n = rho >> 4, i = rho & 15; return 8 * (i >> 2) + 4 * n + (i & 3); }

struct Unit { int pm, pn; };
struct Gemm { const bf16_t* A; const bf16_t* Bt; int M, N, K; };

struct StaticOrder {
    int nM, nN, nwg, G, c;
    __host__ __device__ void init(int M, int N, int G_, int c_) { nM = M / BM; nN = N / BM; nwg = nM * nN; G = G_; c = c_; }
    __host__ __device__ bool next(int i, Unit& u) const {
        const long L = (long)i * G + c; if (L >= nwg) return false;
        int wgid = (int)L; { const int q = nwg / NXCD, r = nwg % NXCD, xcd = wgid % NXCD, off = wgid / NXCD; wgid = (xcd < r ? xcd * (q + 1) : r * (q + 1) + (xcd - r) * q) + off; }
        const int nig = WGM * nN, gid = wgid / nig, fm = gid * WGM, gsz = (nM - fm) < WGM ? (nM - fm) : WGM;
        u.pm = fm + ((wgid % nig) % gsz); u.pn = (wgid % nig) / gsz; return true;
    }
    __device__ __forceinline__ void a_ready(const Unit&) const {}
    __device__ __forceinline__ void done(const Unit&) const {}
};

__device__ __forceinline__ unsigned cvt_pk_bf16(float lo, float hi) { unsigned r; asm volatile("v_cvt_pk_bf16_f32 %0, %1, %2" : "=v"(r) : "v"(lo), "v"(hi)); return r; }
struct EpiBf16 {
    static constexpr bool PERM = true, AFTER_DRAIN = false;
    bf16_t* O; int ldc;
    __device__ __forceinline__ void operator()(const f32x4 (&acc)[2][2][4][2], const Unit& u, int wr, int wc, int fr, int fq) const {
        const int row0 = u.pm * BM + wr * 64 + fr; const int col0 = u.pn * BM + wc * 32 + 8 * fq;
#pragma unroll
        for (int ai = 0; ai < 2; ++ai)
#pragma unroll
            for (int m = 0; m < 4; ++m) { bf16_t* rowp = O + (size_t)(row0 + ai * HALF + m * 16) * ldc + col0;
#pragma unroll
                for (int bj = 0; bj < 2; ++bj) { const f32x4 v0 = acc[ai][bj][m][0], v1 = acc[ai][bj][m][1];
                    u32x4 w; w.x = cvt_pk_bf16(v0[0], v0[1]); w.y = cvt_pk_bf16(v0[2], v0[3]); w.z = cvt_pk_bf16(v1[0], v1[1]); w.w = cvt_pk_bf16(v1[2], v1[3]);
                    *(u32x4*)(rowp + bj * HALF) = w; } }
    }
};
struct EpiVT {
    static constexpr bool PERM = true, AFTER_DRAIN = false;
    bf16_t* O;
    __device__ __forceinline__ void operator()(const f32x4 (&acc)[2][2][4][2], const Unit& u, int wr, int wc, int fr, int fq) const {
        const int row0 = wr * 64 + fr; const int col0 = u.pn * BM + wc * 32 + 8 * fq;
#pragma unroll
        for (int bj = 0; bj < 2; ++bj) { const int tok = col0 + bj * HALF; bf16_t* tp = O + (size_t)(tok >> 6) * (256 * 64) + (tok & 63);
#pragma unroll
            for (int ai = 0; ai < 2; ++ai)
#pragma unroll
                for (int m = 0; m < 4; ++m) { const f32x4 v0 = acc[ai][bj][m][0], v1 = acc[ai][bj][m][1];
                    u32x4 w; w.x = cvt_pk_bf16(v0[0], v0[1]); w.y = cvt_pk_bf16(v0[2], v0[3]); w.z = cvt_pk_bf16(v1[0], v1[1]); w.w = cvt_pk_bf16(v1[2], v1[3]);
                    *(u32x4*)(tp + (row0 + ai * HALF + m * 16) * 64) = w; } }
    }
};
struct EpiSwiGLU {
    static constexpr bool PERM = true, AFTER_DRAIN = false;
    bf16_t* O; int ldc;
    __device__ __forceinline__ void operator()(const f32x4 (&acc)[2][2][4][2], const Unit& u, int wr, int wc, int fr, int fq) const {
        const int row0 = u.pm * BM + wr * 64 + fr; const int col0 = u.pn * HALF + wc * 32 + 8 * fq;
#pragma unroll
        for (int ai = 0; ai < 2; ++ai)
#pragma unroll
            for (int m = 0; m < 4; ++m) { bf16_t* rowp = O + (size_t)(row0 + ai * HALF + m * 16) * ldc + col0;
                float h[8];
#pragma unroll
                for (int n = 0; n < 2; ++n)
#pragma unroll
                    for (int j = 0; j < 4; ++j) { const float g = acc[ai][0][m][n][j], up = acc[ai][1][m][n][j];
                        const float e = __builtin_amdgcn_exp2f(-g * LOG2E_F); h[n * 4 + j] = g * __builtin_amdgcn_rcpf(1.0f + e) * up; }
                u32x4 w; w.x = cvt_pk_bf16(h[0], h[1]); w.y = cvt_pk_bf16(h[2], h[3]); w.z = cvt_pk_bf16(h[4], h[5]); w.w = cvt_pk_bf16(h[6], h[7]);
                *(u32x4*)rowp = w; }
    }
};
struct EpiProj {
    static constexpr bool PERM = true, AFTER_DRAIN = false;
    bf16_t* O; const float* qg; const float* kg; const PG8_LAS float* rope;
    __device__ __forceinline__ void operator()(const f32x4 (&acc)[2][2][4][2], const Unit& u, int wr, int wc, int fr, int fq) const {
        const int pn = u.pn; int ocol; const float* g = nullptr; float sc = 1.f;
        if (pn < 2) { ocol = (4 * pn + wc) * 64; sc = QSCALE_F; }
        else if (pn < 4) { ocol = 512 + (4 * (pn - 2) + wc) * 64; g = qg; sc = QSCALE_F; }
        else if (wc < 2) { ocol = 1024 + wc * 64; }
        else { ocol = 1152 + (wc - 2) * 64; g = kg; }
        const int row0 = u.pm * BM + wr * 64 + fr;
        if (g == nullptr) {
#pragma unroll
            for (int ai = 0; ai < 2; ++ai)
#pragma unroll
                for (int m = 0; m < 4; ++m) { bf16_t* rowp = O + (size_t)(row0 + ai * HALF + m * 16) * 1280 + ocol + 8 * fq;
#pragma unroll
                    for (int bj = 0; bj < 2; ++bj) { const f32x4 v0 = acc[ai][bj][m][0] * sc, v1 = acc[ai][bj][m][1] * sc;
                        u32x4 w; w.x = cvt_pk_bf16(v0[0], v0[1]); w.y = cvt_pk_bf16(v0[2], v0[3]); w.z = cvt_pk_bf16(v1[0], v1[1]); w.w = cvt_pk_bf16(v1[2], v1[3]);
                        *(u32x4*)(rowp + bj * 32) = w; } }
        } else {
            f32x4 gv[2][2];
#pragma unroll
            for (int bj = 0; bj < 2; ++bj)
#pragma unroll
                for (int n = 0; n < 2; ++n) gv[bj][n] = *(const f32x4*)(g + 32 * bj + 8 * fq + 4 * n) * sc;
#pragma unroll
            for (int ai = 0; ai < 2; ++ai)
#pragma unroll
                for (int m = 0; m < 4; ++m) { const int row = row0 + ai * HALF + m * 16; bf16_t* rowp = O + (size_t)row * 1280 + ocol + 8 * fq;
                    float ss = 0.f;
#pragma unroll
                    for (int bj = 0; bj < 2; ++bj)
#pragma unroll
                        for (int n = 0; n < 2; ++n) { const f32x4 v = acc[ai][bj][m][n]; ss += (v[0] * v[0] + v[1] * v[1]) + (v[2] * v[2] + v[3] * v[3]); }
                    ss += __shfl_xor(ss, 16); ss += __shfl_xor(ss, 32);
                    const float rinv = __builtin_amdgcn_rsqf(ss * (1.0f / 64.0f) + 1e-6f);
                    const int spos = row & (row < 32768 ? 4095 : 8191);
#pragma unroll
                    for (int bj = 0; bj < 2; ++bj) { const int pos = bj == 0 ? (spos >> 6) : (spos & 63); f32x4 o[2];
#pragma unroll
                        for (int n = 0; n < 2; ++n) { const f32x4 cs = *(const PG8_LAS f32x4*)(rope + (pos * 16 + 4 * fq + 2 * n) * 2);
                            const f32x4 y = acc[ai][bj][m][n] * rinv * gv[bj][n];
                            o[n][0] = y[0] * cs[0] - y[1] * cs[1]; o[n][1] = y[0] * cs[1] + y[1] * cs[0];
                            o[n][2] = y[2] * cs[2] - y[3] * cs[3]; o[n][3] = y[2] * cs[3] + y[3] * cs[2]; }
                        u32x4 w; w.x = cvt_pk_bf16(o[0][0], o[0][1]); w.y = cvt_pk_bf16(o[0][2], o[0][3]); w.z = cvt_pk_bf16(o[1][0], o[1][1]); w.w = cvt_pk_bf16(o[1][2], o[1][3]);
                        *(u32x4*)(rowp + bj * 32) = w; } }
        }
    }
};
typedef _Float16 f16x8 __attribute__((ext_vector_type(8)));
template <class Epi, class Sched, bool ALIGN_EPI = false, bool SP2 = false, bool F16 = false>
__device__ __forceinline__ void gemm_phase(PG8_LAS unsigned char* lds, const Gemm g, const Sched& S, const Epi& E) {
    int tid_ = threadIdx.x; asm volatile("" : "+v"(tid_));
    const int tid = tid_, wid = __builtin_amdgcn_readfirstlane(tid >> 6), lane = tid & 63, wr = wid >> 2, wc = wid & 3, fr = lane & 15, fq = lane >> 4;
    const int K = g.K, nt = K / BK;
    unsigned voffA[2], voffB[2];
#pragma unroll
    for (int i = 0; i < 2; ++i) { int R, C; stage_rc(tid * 16 + i * 8192, R, C); const int Rb = Epi::PERM ? ((R & ~31) + perm32(R & 31)) : R;
        voffA[i] = (unsigned)(R * K + C) * 2u; voffB[i] = (unsigned)(Rb * K + C) * 2u; }
    const size_t kstep = (size_t)(BK * 2);
    const size_t hstep = (size_t)HALF * K * 2;
    const size_t tstep = 2 * hstep;
    const unsigned ldsw = (unsigned)wid * 1024u;
    const int aoff = lds_byte(wr * 64 + fr, fq * 8), boff = lds_byte(wc * 32 + fr, fq * 8);
#define PG8_SA(b, h) (((b) * 2 + (h)) * HTB)
#define PG8_SB(b, h) ((4 + (b) * 2 + (h)) * HTB)
#define PG8_STAGE(bufoff, gbase, voff) do { _Pragma("unroll") for (int _i = 0; _i < 2; ++_i) \
        __builtin_amdgcn_global_load_lds((const unsigned*)((const char*)(gbase) + (voff)[_i]), (PG8_LAS unsigned*)(lds + (bufoff) + ldsw + _i * 8192), 16, 0, 0); } while (0)
#define PG8_LDA(dst, b, h) do { _Pragma("unroll") for (int m = 0; m < 4; ++m) _Pragma("unroll") for (int k = 0; k < 2; ++k) dst[m][k] = *(const PG8_LAS bf16x8*)(lds + PG8_SA(b, h) + aoff + m * 2048 + k * 1024); } while (0)
#define PG8_LDB(dst, b, h) do { _Pragma("unroll") for (int n = 0; n < 2; ++n) _Pragma("unroll") for (int k = 0; k < 2; ++k) dst[n][k] = *(const PG8_LAS bf16x8*)(lds + PG8_SB(b, h) + boff + n * 2048 + k * 1024); } while (0)
#define PG8_MMA(ai, bj, At, Bt) do { __builtin_amdgcn_s_setprio(1); _Pragma("unroll") for (int m = 0; m < 4; ++m) _Pragma("unroll") for (int n = 0; n < 2; ++n) _Pragma("unroll") for (int k = 0; k < 2; ++k) \
        acc[ai][bj][m][n] = F16 ? __builtin_amdgcn_mfma_f32_16x16x32_f16(__builtin_bit_cast(f16x8, Bt[n][k]), __builtin_bit_cast(f16x8, At[m][k]), acc[ai][bj][m][n], 0, 0, 0) \
                                : __builtin_amdgcn_mfma_f32_16x16x32_bf16(Bt[n][k], At[m][k], acc[ai][bj][m][n], 0, 0, 0); __builtin_amdgcn_s_setprio(0); } while (0)
#define PG8_WAIT_V(n) asm volatile("s_waitcnt vmcnt(" #n ")" ::: "memory")
#define PG8_WAIT_L(n) asm volatile("s_waitcnt lgkmcnt(" #n ")" ::: "memory")
#define PG8_BAR __builtin_amdgcn_s_barrier()
#define PG8_SCHED __builtin_amdgcn_sched_barrier(0)
    Unit cur, nxt; int ui = 0;
    if (!S.next(0, cur)) return;
    f32x4 acc[2][2][4][2];
#pragma unroll
    for (int a = 0; a < 2; ++a)
#pragma unroll
        for (int b = 0; b < 2; ++b)
#pragma unroll
            for (int m = 0; m < 4; ++m)
#pragma unroll
                for (int n = 0; n < 2; ++n) acc[a][b][m][n] = (f32x4){0.f, 0.f, 0.f, 0.f};
    bf16x8 At[4][2], B0[2][2], B1[2][2];
    const char* cA = (const char*)g.A + (size_t)cur.pm * tstep; const char* cB = (const char*)g.Bt + (size_t)cur.pn * tstep;
    S.a_ready(cur);
    if constexpr (SP2) {
        PG8_STAGE(PG8_SB(0, 0), cB, voffB); PG8_STAGE(PG8_SB(0, 1), cB + hstep, voffB); PG8_STAGE(PG8_SA(0, 0), cA, voffA); PG8_STAGE(PG8_SA(0, 1), cA + hstep, voffA);
        if (wr == 1) PG8_BAR;
        PG8_WAIT_V(2); PG8_BAR;
        PG8_STAGE(PG8_SB(1, 0), cB + kstep, voffB); PG8_STAGE(PG8_SA(1, 0), cA + kstep, voffA); PG8_STAGE(PG8_SB(1, 1), cB + hstep + kstep, voffB);
        PG8_WAIT_V(6); PG8_BAR;
    } else {
        PG8_STAGE(PG8_SB(0, 0), cB, voffB); PG8_STAGE(PG8_SA(0, 0), cA, voffA); PG8_STAGE(PG8_SB(0, 1), cB + hstep, voffB); PG8_STAGE(PG8_SA(0, 1), cA + hstep, voffA);
        if (wr == 1) PG8_BAR;
        PG8_WAIT_V(4); PG8_BAR;
        PG8_STAGE(PG8_SB(1, 0), cB + kstep, voffB); PG8_STAGE(PG8_SA(1, 0), cA + kstep, voffA); PG8_STAGE(PG8_SB(1, 1), cB + hstep + kstep, voffB);
        PG8_WAIT_V(6); PG8_BAR;
    }
    for (;;) {
        const bool has_next = S.next(ui + 1, nxt);
        const char* nA = has_next ? (const char*)g.A + (size_t)nxt.pm * tstep : cA; const char* nB = has_next ? (const char*)g.Bt + (size_t)nxt.pn * tstep : cB;
        for (int t = 0; t < nt; t += 2) {
            const bool last = (t == nt - 2);
            const char* a1 = cA + (size_t)(t + 1) * kstep;
            const char* a2 = last ? nA : cA + (size_t)(t + 2) * kstep; const char* b2 = last ? nB : cB + (size_t)(t + 2) * kstep;
            const char* a3 = a2 + kstep; const char* b3 = b2 + kstep;
            if (last && has_next) S.a_ready(nxt);
            if constexpr (SP2) {
            PG8_LDB(B0, 0, 0); PG8_LDB(B1, 0, 1); PG8_SCHED; PG8_LDA(At, 0, 0); PG8_STAGE(PG8_SA(1, 1), a1 + hstep, voffA);
            PG8_WAIT_V(8); PG8_WAIT_L(0); PG8_BAR; PG8_MMA(0, 0, At, B0); PG8_MMA(0, 1, At, B1); PG8_BAR; PG8_SCHED;
            PG8_LDA(At, 0, 1); PG8_STAGE(PG8_SB(0, 0), b2, voffB); PG8_STAGE(PG8_SB(0, 1), b2 + hstep, voffB); PG8_STAGE(PG8_SA(0, 0), a2, voffA);
            PG8_WAIT_V(8); PG8_WAIT_L(0); PG8_BAR; PG8_MMA(1, 0, At, B0); PG8_MMA(1, 1, At, B1); PG8_BAR; PG8_SCHED;
            PG8_LDB(B0, 1, 0); PG8_LDB(B1, 1, 1); PG8_SCHED; PG8_LDA(At, 1, 0); PG8_STAGE(PG8_SA(0, 1), a2 + hstep, voffA);
            PG8_WAIT_V(8); PG8_WAIT_L(0); PG8_BAR; PG8_MMA(0, 0, At, B0); PG8_MMA(0, 1, At, B1); PG8_BAR; PG8_SCHED;
            PG8_LDA(At, 1, 1); PG8_STAGE(PG8_SB(1, 0), b3, voffB); PG8_STAGE(PG8_SB(1, 1), b3 + hstep, voffB); PG8_STAGE(PG8_SA(1, 0), a3, voffA);
            PG8_WAIT_V(8); PG8_WAIT_L(0); PG8_BAR; PG8_MMA(1, 0, At, B0); PG8_MMA(1, 1, At, B1); PG8_BAR; PG8_SCHED;
            } else {
            PG8_LDB(B0, 0, 0); PG8_SCHED; PG8_LDA(At, 0, 0); PG8_STAGE(PG8_SA(1, 1), a1 + hstep, voffA);
            PG8_WAIT_L(8); PG8_BAR; PG8_WAIT_L(0); PG8_MMA(0, 0, At, B0); PG8_BAR; PG8_SCHED;
            PG8_LDB(B1, 0, 1); PG8_STAGE(PG8_SB(0, 0), b2, voffB);
            PG8_BAR; PG8_WAIT_L(0); PG8_MMA(0, 1, At, B1); PG8_BAR;
            PG8_LDA(At, 0, 1); PG8_STAGE(PG8_SA(0, 0), a2, voffA);
            PG8_BAR; PG8_WAIT_L(0); PG8_MMA(1, 0, At, B0); PG8_BAR; PG8_SCHED;
            PG8_STAGE(PG8_SB(0, 1), b2 + hstep, voffB);
            PG8_WAIT_V(6); PG8_BAR; PG8_MMA(1, 1, At, B1); PG8_BAR;
            PG8_LDB(B0, 1, 0); PG8_SCHED; PG8_LDA(At, 1, 0); PG8_STAGE(PG8_SA(0, 1), a2 + hstep, voffA);
            PG8_WAIT_L(8); PG8_BAR; PG8_WAIT_L(0); PG8_MMA(0, 0, At, B0); PG8_BAR; PG8_SCHED;
            PG8_LDB(B1, 1, 1); PG8_STAGE(PG8_SB(1, 0), b3, voffB);
            PG8_BAR; PG8_WAIT_L(0); PG8_MMA(0, 1, At, B1); PG8_BAR;
            PG8_LDA(At, 1, 1); PG8_STAGE(PG8_SA(1, 0), a3, voffA);
            PG8_BAR; PG8_WAIT_L(0); PG8_MMA(1, 0, At, B0); PG8_BAR; PG8_SCHED;
            PG8_STAGE(PG8_SB(1, 1), b3 + hstep, voffB);
            PG8_WAIT_V(6); PG8_BAR; PG8_MMA(1, 1, At, B1); PG8_BAR;
            }
        }
        if constexpr (ALIGN_EPI) { if (wr == 0) PG8_BAR; }
        if constexpr (!Epi::AFTER_DRAIN) { E(acc, cur, wr, wc, fr, fq); S.done(cur); }
        if (!has_next) break;
#pragma unroll
        for (int a = 0; a < 2; ++a)
#pragma unroll
            for (int b = 0; b < 2; ++b)
#pragma unroll
                for (int m = 0; m < 4; ++m)
#pragma unroll
                    for (int n = 0; n < 2; ++n) acc[a][b][m][n] = (f32x4){0.f, 0.f, 0.f, 0.f};
        cur = nxt; cA = nA; cB = nB; ++ui;
        if constexpr (ALIGN_EPI) { if (wr == 1) PG8_BAR; }
    }
    PG8_WAIT_V(0);
    if constexpr (!ALIGN_EPI) { if (wr == 0) PG8_BAR; }
    PG8_BAR;
    if constexpr (Epi::AFTER_DRAIN) { E.fused(acc, cur, wr, wc, fr, fq, lds, wid, lane); S.done(cur); }
#undef PG8_SA
#undef PG8_SB
#undef PG8_STAGE
#undef PG8_LDA
#undef PG8_LDB
#undef PG8_MMA
#undef PG8_WAIT_V
#undef PG8_WAIT_L
#undef PG8_BAR
#undef PG8_SCHED
}
}
namespace att {
#define LAS __attribute__((address_space(3)))
typedef unsigned short bf16_t;
typedef short bf16x8 __attribute__((ext_vector_type(8)));
typedef float f32x16 __attribute__((ext_vector_type(16)));
typedef float f32x4 __attribute__((ext_vector_type(4)));
typedef unsigned u32x4 __attribute__((ext_vector_type(4)));
typedef unsigned u32x2 __attribute__((ext_vector_type(2)));
typedef float f32x2_t __attribute__((ext_vector_type(2))); typedef __bf16 bf16x2_t __attribute__((ext_vector_type(2)));
__device__ __forceinline__ unsigned cvtpk(float lo, float hi) { f32x2_t v = {lo, hi}; bf16x2_t b = __builtin_convertvector(v, bf16x2_t); return __builtin_bit_cast(unsigned, b); }
constexpr int KP = 144;
constexpr int TB = 64 * KP;
constexpr int OFF_K = 0, OFF_V = 2 * TB, OFF_LUT = 4 * TB, ATT_LDS = 4 * TB + 4 * 452 * 4;
constexpr int PITCH_P = 1280, PITCH_VT = 65536, PITCH_O = 1024;

template <int WIN>
__device__ __forceinline__ void attn_unit(LAS unsigned char* lds, const bf16_t* __restrict__ PROJ, const bf16_t* __restrict__ VT, bf16_t* __restrict__ AO,
                                          int rowbase, int S, int hq, int q0, const float* __restrict__ lut_g, float sink2  ) {
    int tid_ = threadIdx.x; asm volatile("" : "+v"(tid_));
    const int tid = tid_, lane = tid & 63, r32 = lane & 31, hi = lane >> 5; const int wid = __builtin_amdgcn_readfirstlane(tid >> 6);
    const int kvh = hq >> 2;
    const int qcol = WIN ? hq * 64 : 512 + hq * 64;
    const int kcol = WIN ? 1024 + kvh * 64 : 1152 + kvh * 64;
    const int vrow0 = WIN ? kvh * 64 : 128 + kvh * 64;
    const int ocol = WIN ? hq * 64 : 512 + hq * 64;
    int kt0 = 0, kt1 = S >> 6;
    if (WIN) { const int lo = q0 - 128, hi_ = q0 + 256 + 128; kt0 = (lo < 0 ? 0 : lo) >> 6; kt1 = (hi_ > S ? S : hi_) >> 6; }
    const int krow = tid >> 3, kch = tid & 7;
    const bf16_t* ksrc = PROJ + (size_t)(rowbase + krow) * PITCH_P + kcol + kch * 8;
    const bf16_t* vsrc = VT + ((size_t)(rowbase >> 6) * 256 + vrow0 + krow) * 64 + kch * 8;
    const int kdst = OFF_K + krow * KP + kch * 16;
    const int vdst = OFF_V + krow * KP + (kch >> 1) * 32 + (kch & 1) * 8;
    LAS float* lut = (LAS float*)(lds + OFF_LUT);
    if (WIN) { if (tid < 257) lut[tid] = lut_g[tid]; }
    const int qw = q0 + wid * 32;
    const bf16_t* qp = PROJ + (size_t)(rowbase + qw + r32) * PITCH_P + qcol + hi * 8;
    bf16x8 qf[4];
#pragma unroll
    for (int ds = 0; ds < 4; ++ds) qf[ds] = *(const bf16x8*)(qp + ds * 16);
    u32x4 kreg = *(const u32x4*)(ksrc + (size_t)kt0 * 64 * PITCH_P);
    u32x4 vreg = *(const u32x4*)(vsrc + (size_t)kt0 * 16384);
    *(LAS u32x4*)(lds + kdst) = kreg;
    *(LAS u32x2*)(lds + vdst) = (u32x2){vreg.x, vreg.y}; *(LAS u32x2*)(lds + vdst + 16) = (u32x2){vreg.z, vreg.w};
    if (kt0 + 1 < kt1) { kreg = *(const u32x4*)(ksrc + (size_t)(kt0 + 1) * 64 * PITCH_P); vreg = *(const u32x4*)(vsrc + (size_t)(kt0 + 1) * 16384); }
    float m = WIN ? sink2 : 0.f, l = WIN ? 0.5f : 0.f;
    f32x16 negb; { const float nb_ = WIN ? 0.f : -sink2;
#pragma unroll
      for (int r = 0; r < 16; ++r) negb[r] = nb_; }
    f32x16 o0 = {}, o1 = {};
    __syncthreads();
    for (int t = kt0; t < kt1; ++t) {
        const int cur = (t - kt0) & 1;
        if (t + 1 < kt1) {
            const int nb = (cur ^ 1) * TB;
            *(LAS u32x4*)(lds + nb + kdst) = kreg;
            *(LAS u32x2*)(lds + nb + vdst) = (u32x2){vreg.x, vreg.y}; *(LAS u32x2*)(lds + nb + vdst + 16) = (u32x2){vreg.z, vreg.w};
            if (t + 2 < kt1) { kreg = *(const u32x4*)(ksrc + (size_t)(t + 2) * 64 * PITCH_P); vreg = *(const u32x4*)(vsrc + (size_t)(t + 2) * 16384); }
        }
        const int k0 = t * 64;
        bool active = true;
        if (WIN) active = (k0 + 63 >= qw - 128) && (k0 <= qw + 31 + 128);
        if (active) {
            const LAS unsigned char* kb = lds + OFF_K + cur * TB + r32 * KP + hi * 16;
            f32x16 sA = negb, sB = negb;
#pragma unroll
            for (int ds = 0; ds < 4; ++ds) {
                const bf16x8 ka = *(const LAS bf16x8*)(kb + ds * 32);
                const bf16x8 kb2 = *(const LAS bf16x8*)(kb + 32 * KP + ds * 32);
                sA = __builtin_amdgcn_mfma_f32_32x32x16_bf16(ka, qf[ds], sA, 0, 0, 0);
                sB = __builtin_amdgcn_mfma_f32_32x32x16_bf16(kb2, qf[ds], sB, 0, 0, 0);
            }
            if (WIN) {
                const int qpos = qw + r32;
#pragma unroll
                for (int r = 0; r < 16; ++r) {
                    const int key = k0 + (r & 3) + 8 * (r >> 2) + 4 * hi;
                    int relA = key - qpos + 128, relB = relA + 32;
                    const bool vA = (relA >= 0) && (relA <= 256), vB = (relB >= 0) && (relB <= 256);
                    relA = relA < 0 ? 0 : (relA > 256 ? 256 : relA); relB = relB < 0 ? 0 : (relB > 256 ? 256 : relB);
                    sA[r] = vA ? sA[r] + lut[relA] : -1e30f; sB[r] = vB ? sB[r] + lut[relB] : -1e30f;
                }
            }
            if (WIN) {
            float mx = fmaxf(sA[0], sB[0]);
#pragma unroll
            for (int r = 1; r < 16; ++r) mx = fmaxf(mx, fmaxf(sA[r], sB[r]));
            mx = fmaxf(mx, __shfl_xor(mx, 32));
            const float mn = fmaxf(m, mx);
            const float alpha = __builtin_amdgcn_exp2f(m - mn);
            m = mn;
            float ps = 0.f;
#pragma unroll
            for (int r = 0; r < 16; ++r) { sA[r] = __builtin_amdgcn_exp2f(sA[r] - mn); sB[r] = __builtin_amdgcn_exp2f(sB[r] - mn); ps += sA[r] + sB[r]; }
            l = l * alpha + ps;
#pragma unroll
            for (int r = 0; r < 16; ++r) { o0[r] *= alpha; o1[r] *= alpha; }
            } else {
                float ps = 0.f;
#pragma unroll
                for (int r = 0; r < 16; ++r) { sA[r] = __builtin_amdgcn_exp2f(sA[r]); sB[r] = __builtin_amdgcn_exp2f(sB[r]); ps += sA[r] + sB[r]; }
                l += ps;
            }
            bf16x8 pk[4];
            { u32x4 w;
              w.x = cvtpk(sA[0], sA[1]); w.y = cvtpk(sA[2], sA[3]); w.z = cvtpk(sA[4], sA[5]); w.w = cvtpk(sA[6], sA[7]); pk[0] = __builtin_bit_cast(bf16x8, w);
              w.x = cvtpk(sA[8], sA[9]); w.y = cvtpk(sA[10], sA[11]); w.z = cvtpk(sA[12], sA[13]); w.w = cvtpk(sA[14], sA[15]); pk[1] = __builtin_bit_cast(bf16x8, w);
              w.x = cvtpk(sB[0], sB[1]); w.y = cvtpk(sB[2], sB[3]); w.z = cvtpk(sB[4], sB[5]); w.w = cvtpk(sB[6], sB[7]); pk[2] = __builtin_bit_cast(bf16x8, w);
              w.x = cvtpk(sB[8], sB[9]); w.y = cvtpk(sB[10], sB[11]); w.z = cvtpk(sB[12], sB[13]); w.w = cvtpk(sB[14], sB[15]); pk[3] = __builtin_bit_cast(bf16x8, w); }
            const LAS unsigned char* vb = lds + OFF_V + cur * TB + r32 * KP + hi * 16;
#pragma unroll
            for (int s = 0; s < 4; ++s) {
                const bf16x8 va = *(const LAS bf16x8*)(vb + s * 32);
                const bf16x8 vb2 = *(const LAS bf16x8*)(vb + 32 * KP + s * 32);
                o0 = __builtin_amdgcn_mfma_f32_32x32x16_bf16(va, pk[s], o0, 0, 0, 0);
                o1 = __builtin_amdgcn_mfma_f32_32x32x16_bf16(vb2, pk[s], o1, 0, 0, 0);
            }
        }
        asm volatile("s_waitcnt lgkmcnt(0)\n\ts_barrier" ::: "memory");
    }
    const float lt = l + __shfl_xor(l, 32);
    const float inv = 1.0f / lt;
    bf16_t* op = AO + (size_t)(rowbase + qw + r32) * PITCH_O + ocol + 4 * hi;
#pragma unroll
    for (int g4 = 0; g4 < 4; ++g4) {
        u32x2 w0, w1;
        w0.x = cvtpk(o0[4 * g4] * inv, o0[4 * g4 + 1] * inv); w0.y = cvtpk(o0[4 * g4 + 2] * inv, o0[4 * g4 + 3] * inv);
        w1.x = cvtpk(o1[4 * g4] * inv, o1[4 * g4 + 1] * inv); w1.y = cvtpk(o1[4 * g4 + 2] * inv, o1[4 * g4 + 3] * inv);
        *(u32x2*)(op + 8 * g4) = w0; *(u32x2*)(op + 32 + 8 * g4) = w1;
    }
}

#define ATT_BAR() asm volatile("s_waitcnt lgkmcnt(0)\n\ts_barrier" ::: "memory")
__device__ __forceinline__ void attn_global(LAS unsigned char* lds, const bf16_t* __restrict__ PROJ, const bf16_t* __restrict__ VT, bf16_t* __restrict__ AO,
                                            int rowbase, int S, int hq, int q0, float bound2) {
    int tid_ = threadIdx.x; asm volatile("" : "+v"(tid_));
    const int tid = tid_, lane = tid & 63, r32 = lane & 31, hi = lane >> 5; const int wid = __builtin_amdgcn_readfirstlane(tid >> 6);
    const int kvh = hq >> 2, qcol = 512 + hq * 64, kcol = 1152 + kvh * 64, vrow0 = 128 + kvh * 64, ocol = 512 + hq * 64;
    const int T = S >> 6;
    const int krow = tid >> 3, kch = tid & 7;
    const bf16_t* ksrc = PROJ + (size_t)(rowbase + krow) * PITCH_P + kcol + kch * 8;
    const bf16_t* vsrc = VT + ((size_t)(rowbase >> 6) * 256 + vrow0 + krow) * 64 + kch * 8;
    constexpr int RK = 0, RV = 4 * TB;
    const int kdst = RK + krow * KP + kch * 16;
    const int vdst = RV + krow * KP + (kch >> 1) * 32 + (kch & 1) * 8;
    const int qw = q0 + wid * 32;
    const bf16_t* qp = PROJ + (size_t)(rowbase + qw + r32) * PITCH_P + qcol + hi * 8;
    bf16x8 qf[4];
#pragma unroll
    for (int ds = 0; ds < 4; ++ds) qf[ds] = *(const bf16x8*)(qp + ds * 16);
#define LDK(t) (*(const u32x4*)(ksrc + (size_t)(t) * 64 * PITCH_P))
#define LDV(t) (*(const u32x4*)(vsrc + (size_t)(t) * 16384))
#define STK(slot, reg) (*(LAS u32x4*)(lds + (slot) * TB + kdst) = (reg))
#define STV(slot, reg) do { *(LAS u32x2*)(lds + (slot) * TB + vdst) = (u32x2){(reg).x, (reg).y}; *(LAS u32x2*)(lds + (slot) * TB + vdst + 16) = (u32x2){(reg).z, (reg).w}; } while (0)
    u32x4 kra, krb, vra, vrb;
    kra = LDK(0); krb = LDK(1); vra = LDV(0); vrb = LDV(1);
    STK(0, kra); STK(1, krb); STV(0, vra); STV(1, vrb);
    kra = LDK(2); STK(2, kra);
    kra = LDK(3); krb = LDK(4); vra = LDV(2); vrb = LDV(3);
    const f32x16 zero16 = {};
    f32x16 lacc = {};
    const bf16x8 ones8 = {0x3F80, 0x3F80, 0x3F80, 0x3F80, 0x3F80, 0x3F80, 0x3F80, 0x3F80};
    f32x16 o0 = {}, o1 = {}, sA, sB, nA, nB;
    const LAS unsigned char* kfb = lds + RK + r32 * KP + hi * 16;
    const LAS unsigned char* vfb = lds + RV + r32 * KP + hi * 16;
#define QK_TILE(SA, SB, slot) do { _Pragma("unroll") for (int ds = 0; ds < 4; ++ds) { \
        const bf16x8 ka_ = *(const LAS bf16x8*)(kfb + (slot) * TB + ds * 32), kb_ = *(const LAS bf16x8*)(kfb + (slot) * TB + 32 * KP + ds * 32); \
        SA = __builtin_amdgcn_mfma_f32_32x32x16_bf16(ka_, qf[ds], ds == 0 ? zero16 : SA, 0, 0, 0); \
        SB = __builtin_amdgcn_mfma_f32_32x32x16_bf16(kb_, qf[ds], ds == 0 ? zero16 : SB, 0, 0, 0); } } while (0)
    ATT_BAR();
    QK_TILE(sA, sB, 0);
    ATT_BAR();
#define ATT_HALF(SA, SB, NA, NB, ks, vs, DOQK) do { \
        if (DOQK) QK_TILE(NA, NB, ks); \
        _Pragma("unroll") for (int r = 0; r < 16; ++r) { SA[r] = __builtin_amdgcn_exp2f(SA[r]); SB[r] = __builtin_amdgcn_exp2f(SB[r]); } \
        bf16x8 pk_[4]; { u32x4 w_; \
          w_.x = cvtpk(SA[0], SA[1]); w_.y = cvtpk(SA[2], SA[3]); w_.z = cvtpk(SA[4], SA[5]); w_.w = cvtpk(SA[6], SA[7]); pk_[0] = __builtin_bit_cast(bf16x8, w_); \
          w_.x = cvtpk(SA[8], SA[9]); w_.y = cvtpk(SA[10], SA[11]); w_.z = cvtpk(SA[12], SA[13]); w_.w = cvtpk(SA[14], SA[15]); pk_[1] = __builtin_bit_cast(bf16x8, w_); \
          w_.x = cvtpk(SB[0], SB[1]); w_.y = cvtpk(SB[2], SB[3]); w_.z = cvtpk(SB[4], SB[5]); w_.w = cvtpk(SB[6], SB[7]); pk_[2] = __builtin_bit_cast(bf16x8, w_); \
          w_.x = cvtpk(SB[8], SB[9]); w_.y = cvtpk(SB[10], SB[11]); w_.z = cvtpk(SB[12], SB[13]); w_.w = cvtpk(SB[14], SB[15]); pk_[3] = __builtin_bit_cast(bf16x8, w_); } \
        _Pragma("unroll") for (int s = 0; s < 4; ++s) { \
            const bf16x8 va_ = *(const LAS bf16x8*)(vfb + (vs) * TB + s * 32), vb_ = *(const LAS bf16x8*)(vfb + (vs) * TB + 32 * KP + s * 32); \
            o0 = __builtin_amdgcn_mfma_f32_32x32x16_bf16(va_, pk_[s], o0, 0, 0, 0); \
            o1 = __builtin_amdgcn_mfma_f32_32x32x16_bf16(vb_, pk_[s], o1, 0, 0, 0); \
            lacc = __builtin_amdgcn_mfma_f32_32x32x16_bf16(ones8, pk_[s], lacc, 0, 0, 0); } } while (0)
#define ATT_DSTEP(t, p, FULL) do { \
        if (FULL || (t) + 3 < T) STK(((p) + 3) & 3, kra); \
        if (FULL || (t) + 4 < T) STK((p), krb); \
        if (FULL || (t) + 2 < T) STV(((p) + 2) & 3, vra); \
        if (FULL || (t) + 3 < T) STV(((p) + 3) & 3, vrb); \
        if (FULL || (t) + 5 < T) kra = LDK((t) + 5); \
        if (FULL || (t) + 6 < T) krb = LDK((t) + 6); \
        if (FULL || (t) + 4 < T) vra = LDV((t) + 4); \
        if (FULL || (t) + 5 < T) vrb = LDV((t) + 5); \
        ATT_HALF(sA, sB, nA, nB, ((p) + 1) & 3, (p), (FULL || (t) + 1 < T)); \
        ATT_HALF(nA, nB, sA, sB, ((p) + 2) & 3, ((p) + 1) & 3, (FULL || (t) + 2 < T)); \
        ATT_BAR(); } while (0)
    int t = 0;
#pragma unroll 1
    for (; t + 10 < T; t += 4) { ATT_DSTEP(t, 0, true); ATT_DSTEP(t + 2, 2, true); }
#pragma unroll 1
    for (; t < T; t += 4) { ATT_DSTEP(t, 0, false); ATT_DSTEP(t + 2, 2, false); }
#undef ATT_DSTEP
#undef ATT_HALF
#undef QK_TILE
#undef LDK
#undef LDV
#undef STK
#undef STV
    const float inv = 1.0f / lacc[0];
    bf16_t* op = AO + (size_t)(rowbase + qw + r32) * PITCH_O + ocol + 4 * hi;
#pragma unroll
    for (int g4 = 0; g4 < 4; ++g4) {
        u32x2 w0, w1;
        w0.x = cvtpk(o0[4 * g4] * inv, o0[4 * g4 + 1] * inv); w0.y = cvtpk(o0[4 * g4 + 2] * inv, o0[4 * g4 + 3] * inv);
        w1.x = cvtpk(o1[4 * g4] * inv, o1[4 * g4 + 1] * inv); w1.y = cvtpk(o1[4 * g4 + 2] * inv, o1[4 * g4 + 3] * inv);
        *(u32x2*)(op + 8 * g4) = w0; *(u32x2*)(op + 32 + 8 * g4) = w1;
    }
}

__device__ __forceinline__ void attn_win(LAS unsigned char* lds, const bf16_t* __restrict__ PROJ, const bf16_t* __restrict__ VT, bf16_t* __restrict__ AO,
                                         int rowbase, int S, int kvh, int q0, const float* __restrict__ lut_g  , const float* __restrict__ sinkp  ) {
    int tid_ = threadIdx.x; asm volatile("" : "+v"(tid_));
    const int tid = tid_, lane = tid & 63, r32 = lane & 31, hi = lane >> 5; const int wid = __builtin_amdgcn_readfirstlane(tid >> 6);
    const int hq = kvh * 4 + (wid >> 1);
    const int qcol = hq * 64, kcol = 1024 + kvh * 64, vrow0 = kvh * 64, ocol = hq * 64;
    const int lo = q0 - 128, hi_ = q0 + 64 + 128;
    const int kt0 = (lo < 0 ? 0 : lo) >> 6, kt1 = (hi_ > S ? S : hi_) >> 6;
    const int krow = tid >> 3, kch = tid & 7;
    const bf16_t* ksrc = PROJ + (size_t)(rowbase + krow) * PITCH_P + kcol + kch * 8;
    const bf16_t* vsrc = VT + ((size_t)(rowbase >> 6) * 256 + vrow0 + krow) * 64 + kch * 8;
    const int kdst = OFF_K + krow * KP + kch * 16;
    const int vdst = OFF_V + krow * KP + (kch >> 1) * 32 + (kch & 1) * 8;
    LAS float* lut4 = (LAS float*)(lds + OFF_LUT);
    for (int i = tid; i < 4 * 452; i += 512) lut4[i] = lut_g[kvh * 4 * 452 + i];
    const LAS float* lut = lut4 + (wid >> 1) * 452;
    const float sink2 = sinkp[hq] * LOG2E_F;
    const int qw = q0 + (wid & 1) * 32;
    const bf16_t* qp = PROJ + (size_t)(rowbase + qw + r32) * PITCH_P + qcol + hi * 8;
    bf16x8 qf[4];
#pragma unroll
    for (int ds = 0; ds < 4; ++ds) qf[ds] = *(const bf16x8*)(qp + ds * 16);
    u32x4 kreg = *(const u32x4*)(ksrc + (size_t)kt0 * 64 * PITCH_P);
    u32x4 vreg = *(const u32x4*)(vsrc + (size_t)kt0 * 16384);
    *(LAS u32x4*)(lds + kdst) = kreg;
    *(LAS u32x2*)(lds + vdst) = (u32x2){vreg.x, vreg.y}; *(LAS u32x2*)(lds + vdst + 16) = (u32x2){vreg.z, vreg.w};
    if (kt0 + 1 < kt1) { kreg = *(const u32x4*)(ksrc + (size_t)(kt0 + 1) * 64 * PITCH_P); vreg = *(const u32x4*)(vsrc + (size_t)(kt0 + 1) * 16384); }
    float m = sink2, l = 0.5f;
    f32x16 o0 = {}, o1 = {};
    asm volatile("s_waitcnt lgkmcnt(0)\n\ts_barrier" ::: "memory");
    for (int t = kt0; t < kt1; ++t) {
        const int cur = (t - kt0) & 1;
        if (t + 1 < kt1) {
            const int nb = (cur ^ 1) * TB;
            *(LAS u32x4*)(lds + nb + kdst) = kreg;
            *(LAS u32x2*)(lds + nb + vdst) = (u32x2){vreg.x, vreg.y}; *(LAS u32x2*)(lds + nb + vdst + 16) = (u32x2){vreg.z, vreg.w};
            if (t + 2 < kt1) { kreg = *(const u32x4*)(ksrc + (size_t)(t + 2) * 64 * PITCH_P); vreg = *(const u32x4*)(vsrc + (size_t)(t + 2) * 16384); }
        }
        const int k0 = t * 64;
        if ((k0 + 63 >= qw - 128) && (k0 <= qw + 31 + 128)) {
            const LAS unsigned char* kb = lds + OFF_K + cur * TB + r32 * KP + hi * 16;
            f32x16 sA = {}, sB = {};
#pragma unroll
            for (int ds = 0; ds < 4; ++ds) {
                const bf16x8 ka = *(const LAS bf16x8*)(kb + ds * 32);
                const bf16x8 kb2 = *(const LAS bf16x8*)(kb + 32 * KP + ds * 32);
                sA = __builtin_amdgcn_mfma_f32_32x32x16_bf16(ka, qf[ds], sA, 0, 0, 0);
                sB = __builtin_amdgcn_mfma_f32_32x32x16_bf16(kb2, qf[ds], sB, 0, 0, 0);
            }
            { const LAS float* lp = lut + (k0 - (qw + r32) + 224 + 4 * hi);
#pragma unroll
              for (int r = 0; r < 16; ++r) { sA[r] += lp[(r & 3) + 8 * (r >> 2)]; sB[r] += lp[32 + (r & 3) + 8 * (r >> 2)]; } }
            float mx = fmaxf(sA[0], sB[0]);
#pragma unroll
            for (int r = 1; r < 16; ++r) mx = fmaxf(mx, fmaxf(sA[r], sB[r]));
            mx = fmaxf(mx, __shfl_xor(mx, 32));
            const float mn = fmaxf(m, mx);
            const float alpha = __builtin_amdgcn_exp2f(m - mn);
            m = mn;
            float ps = 0.f;
#pragma unroll
            for (int r = 0; r < 16; ++r) { sA[r] = __builtin_amdgcn_exp2f(sA[r] - mn); sB[r] = __builtin_amdgcn_exp2f(sB[r] - mn); ps += sA[r] + sB[r]; }
            l = l * alpha + ps;
#pragma unroll
            for (int r = 0; r < 16; ++r) { o0[r] *= alpha; o1[r] *= alpha; }
            bf16x8 pk[4];
            { u32x4 w;
              w.x = cvtpk(sA[0], sA[1]); w.y = cvtpk(sA[2], sA[3]); w.z = cvtpk(sA[4], sA[5]); w.w = cvtpk(sA[6], sA[7]); pk[0] = __builtin_bit_cast(bf16x8, w);
              w.x = cvtpk(sA[8], sA[9]); w.y = cvtpk(sA[10], sA[11]); w.z = cvtpk(sA[12], sA[13]); w.w = cvtpk(sA[14], sA[15]); pk[1] = __builtin_bit_cast(bf16x8, w);
              w.x = cvtpk(sB[0], sB[1]); w.y = cvtpk(sB[2], sB[3]); w.z = cvtpk(sB[4], sB[5]); w.w = cvtpk(sB[6], sB[7]); pk[2] = __builtin_bit_cast(bf16x8, w);
              w.x = cvtpk(sB[8], sB[9]); w.y = cvtpk(sB[10], sB[11]); w.z = cvtpk(sB[12], sB[13]); w.w = cvtpk(sB[14], sB[15]); pk[3] = __builtin_bit_cast(bf16x8, w); }
            const LAS unsigned char* vb = lds + OFF_V + cur * TB + r32 * KP + hi * 16;
#pragma unroll
            for (int s = 0; s < 4; ++s) {
                const bf16x8 va = *(const LAS bf16x8*)(vb + s * 32);
                const bf16x8 vb2 = *(const LAS bf16x8*)(vb + 32 * KP + s * 32);
                o0 = __builtin_amdgcn_mfma_f32_32x32x16_bf16(va, pk[s], o0, 0, 0, 0);
                o1 = __builtin_amdgcn_mfma_f32_32x32x16_bf16(vb2, pk[s], o1, 0, 0, 0);
            }
        }
        asm volatile("s_waitcnt lgkmcnt(0)\n\ts_barrier" ::: "memory");
    }
    const float lt = l + __shfl_xor(l, 32);
    const float inv = 1.0f / lt;
    bf16_t* op = AO + (size_t)(rowbase + qw + r32) * PITCH_O + ocol + 4 * hi;
#pragma unroll
    for (int g4 = 0; g4 < 4; ++g4) {
        u32x2 w0, w1;
        w0.x = cvtpk(o0[4 * g4] * inv, o0[4 * g4 + 1] * inv); w0.y = cvtpk(o0[4 * g4 + 2] * inv, o0[4 * g4 + 3] * inv);
        w1.x = cvtpk(o1[4 * g4] * inv, o1[4 * g4 + 1] * inv); w1.y = cvtpk(o1[4 * g4 + 2] * inv, o1[4 * g4 + 3] * inv);
        *(u32x2*)(op + 8 * g4) = w0; *(u32x2*)(op + 32 + 8 * g4) = w1;
    }
}
}

typedef unsigned short bf16;
typedef unsigned v4u __attribute__((ext_vector_type(4)));
typedef unsigned v2u __attribute__((ext_vector_type(2)));
typedef float f32x4 __attribute__((ext_vector_type(4)));
constexpr int NWAVES = 8;
#ifndef DUP_ATT
#define DUP_ATT 1
#endif
#ifndef DUP_FFN1
#define DUP_FFN1 1
#endif
#ifndef DUP_LN
#define DUP_LN 1
#endif
#ifndef DUP_PRO
#define DUP_PRO 1
#endif
#ifndef DUP_P1
#define DUP_P1 1
#endif
#ifndef DUP_OP
#define DUP_OP 1
#endif
#ifndef DUP_DN
#define DUP_DN 1
#endif
constexpr int DM = 1024, DIN = 1536, DFF = 2816, DEPTH = 4, MTOT = 65536, MHALF = 32768, NPROJ = 1280;
constexpr size_t MiB = 1u << 20;
constexpr size_t WS_ROPE = 0;
constexpr size_t WS_LUT = 32768;
constexpr size_t WS_STATS = 256 * 1024;
constexpr size_t WS_W = 1 * MiB;
constexpr size_t W_P = 0, W_V = W_P + (size_t)1280 * 1024, W_O = W_V + (size_t)256 * 1024, W_GU = W_O + (size_t)1024 * 1024, W_D = W_GU + (size_t)5632 * 1024, W_LAYER = W_D + (size_t)1024 * 2816;
constexpr size_t WS_XB = 88 * MiB;
constexpr size_t WS_PROJ = 216 * MiB;
constexpr size_t WS_VT = 376 * MiB;
constexpr size_t WS_H = 216 * MiB;
constexpr size_t WS_MX0 = 408 * MiB;
constexpr size_t WS_END = 472 * MiB;
static_assert(W_LAYER * 2 * 3 >= (size_t)MHALF * DM * 2 && WS_W + W_LAYER * 2 * DEPTH <= WS_XB && WS_H + (size_t)MHALF * DFF * 2 <= WS_END, "ws map");
constexpr int LDS_ROPE = 131328;
constexpr int LDS_BYTES = 147968;

constexpr size_t WS_BAR = 65536;
#define XB_TMO      128
#define XB_XCNT(j)  (256  + 64 * (j))
#define XB_XSUB(j)  (1280 + 64 * (j))
#define XB_XGEN(j)  (2304 + 64 * (j))
#define XB_TOP      3328
#define XB_TOPGEN   3392
#define XCD_BAR_WORDS 3456
#define XB_SPIN_CAP (1u << 18)

__device__ __forceinline__ unsigned xb_ld(unsigned* p)              { return __hip_atomic_load(p, __ATOMIC_RELAXED, __HIP_MEMORY_SCOPE_AGENT); }
__device__ __forceinline__ unsigned xb_add(unsigned* p, unsigned v) { return __hip_atomic_fetch_add(p, v, __ATOMIC_RELAXED, __HIP_MEMORY_SCOPE_AGENT); }
__device__ __forceinline__ unsigned xb_xcc_id() { return (unsigned)__builtin_amdgcn_s_getreg((3 << 11) | 20) & 0xFu; }
#define XB_SPIN(cond, bar) do { unsigned _sp = 0; while (cond) { __builtin_amdgcn_s_sleep(1); \
    if ((++_sp & 255u) == 0u) { if (xb_ld(&(bar)[XB_TMO])) break; if (_sp > XB_SPIN_CAP) { atomicAdd(&(bar)[XB_TMO], 1u); break; } } } } while (0)

struct XcdBarrier {
    unsigned* bar; unsigned x;
    volatile LAS unsigned* st;
};

__device__ __forceinline__ XcdBarrier xcd_barrier_post(unsigned* bar, volatile LAS unsigned* st) {
    XcdBarrier b; b.bar = bar; b.x = xb_xcc_id(); b.st = st;
    if (threadIdx.x == 0) (void)xb_add(&bar[XB_XCNT(b.x)], 1u);
    return b;
}
__device__ __forceinline__ void xcd_barrier_complete(unsigned* bar, unsigned x, unsigned& nloc, unsigned& nx) {
    const unsigned G = gridDim.x * gridDim.y * gridDim.z;
    unsigned sum, cnt, mine, sp = 0u;
    for (;;) {
        sum = 0u; cnt = 0u; mine = 0u;
#pragma unroll
        for (unsigned j = 0; j < 16; ++j) { const unsigned c = xb_ld(&bar[XB_XCNT(j)]); sum += c; cnt += (c > 0u) ? 1u : 0u; mine = (j == x) ? c : mine; }
        if (sum == G) break;
        __builtin_amdgcn_s_sleep(1);
        if ((++sp & 255u) == 0u) { if (xb_ld(&bar[XB_TMO])) break; if (sp > XB_SPIN_CAP) { atomicAdd(&bar[XB_TMO], 1u); break; } }
    }
    nloc = mine > 0u ? mine : 1u; nx = cnt > 0u ? cnt : 1u;
}

__device__ __forceinline__ void xcd_barrier(const XcdBarrier& b) {
    asm volatile("s_waitcnt vmcnt(0)" ::: "memory");
    __syncthreads();
    if (threadIdx.x == 0) {
        unsigned* bar = b.bar;
        __builtin_amdgcn_s_waitcnt(0);
        unsigned nloc = b.st[0], nx = b.st[1];
        if (nloc == 0u) { xcd_barrier_complete(bar, b.x, nloc, nx); b.st[0] = nloc; b.st[1] = nx; }
        const unsigned old = xb_add(&bar[XB_XSUB(b.x)], 1u);
        const unsigned gen = old / nloc;
        if (old + 1u == (gen + 1u) * nloc) {
            __builtin_amdgcn_fence(__ATOMIC_RELEASE, "agent");
            asm volatile("s_waitcnt vmcnt(0)" ::: "memory");
            const unsigned og = xb_add(&bar[XB_TOP], 1u);
            const unsigned tg = og / nx;
            if (og + 1u == (tg + 1u) * nx) xb_add(&bar[XB_TOPGEN], 1u);
            else XB_SPIN(xb_ld(&bar[XB_TOPGEN]) == tg, bar);
            __builtin_amdgcn_fence(__ATOMIC_ACQUIRE, "agent");
            xb_add(&bar[XB_XGEN(b.x)], 1u);
            asm volatile("s_waitcnt vmcnt(0)" ::: "memory");
        } else {
            XB_SPIN(xb_ld(&bar[XB_XGEN(b.x)]) == gen, bar);
            __builtin_amdgcn_fence(__ATOMIC_ACQUIRE, "agent");
            asm volatile("s_waitcnt vmcnt(0)" ::: "memory");
        }
    }
    __syncthreads();
}

struct Args { const float* in[15]; float* out; unsigned char* ws; int ph_lo, ph_hi; };

__device__ __forceinline__ unsigned f2bf(float f) { unsigned u = __builtin_bit_cast(unsigned, f); return (u + 0x7fffu + ((u >> 16) & 1u)) >> 16; }
__device__ __forceinline__ unsigned pk2(float lo, float hi) { return f2bf(lo) | (f2bf(hi) << 16); }
typedef _Float16 h16x2 __attribute__((ext_vector_type(2))); typedef _Float16 h16x4 __attribute__((ext_vector_type(4))); typedef float f32x2p __attribute__((ext_vector_type(2)));
__device__ __forceinline__ unsigned pkh(float lo, float hi) { f32x2p v = {lo, hi}; return __builtin_bit_cast(unsigned, __builtin_convertvector(v, h16x2)); }
template <bool H> __device__ __forceinline__ unsigned pk16(float lo, float hi) { return H ? pkh(lo, hi) : pk2(lo, hi); }
__device__ __forceinline__ float wave_sum(float v) {
#pragma unroll
    for (int o = 1; o < 64; o <<= 1) v += __shfl_xor(v, o);
    return v;
}
template <bool H>
__device__ __forceinline__ void transpose_item(const float* __restrict__ W, int ldw, int col0, int k0, bf16* __restrict__ WT, int K, int n0, LAS float* scr, int lane) {
#pragma unroll 8
    for (int i = 0; i < 32; ++i) { const int kk = 2 * i + (lane >> 5); scr[kk * 33 + (lane & 31)] = W[(size_t)(k0 + kk) * ldw + col0 + (lane & 31)]; }
    asm volatile("s_waitcnt lgkmcnt(0)" ::: "memory");
    const int c = lane & 7;
#pragma unroll
    for (int j = 0; j < 4; ++j) { const int n = (lane >> 3) + 8 * j; const LAS float* s = scr + (8 * c) * 33 + n;
        v4u o; o.x = pk16<H>(s[0 * 33], s[1 * 33]); o.y = pk16<H>(s[2 * 33], s[3 * 33]); o.z = pk16<H>(s[4 * 33], s[5 * 33]); o.w = pk16<H>(s[6 * 33], s[7 * 33]);
        *(v4u*)(WT + (size_t)(n0 + n) * K + k0 + 8 * c) = o; }
    asm volatile("s_waitcnt lgkmcnt(0)" ::: "memory");
}

typedef const __attribute__((address_space(4))) Args* CArgsP;
__device__ __forceinline__ void prologue(CArgsP ap_, LAS unsigned char* lds, int gw, int ngw, int wave, int lane) {
    Args a;
#pragma unroll
    for (int i = 0; i < 15; ++i) a.in[i] = ap_->in[i];
    a.out = ap_->out; a.ws = ap_->ws; a.ph_lo = 0; a.ph_hi = 0;
    unsigned char* ws = a.ws;
    LAS float* scr = (LAS float*)(lds + wave * 16384);
    constexpr int I_P = 16 * 40, I_V = 16 * 8, I_O = 16 * 32, I_GU = 16 * 176, I_D = 44 * 32, I_LAYER = I_P + I_V + I_O + I_GU + I_D;
    for (int it = gw; it < I_LAYER * DEPTH; it += ngw) {
        const int l = it / I_LAYER; int r = it % I_LAYER;
        bf16* wl = (bf16*)(ws + WS_W) + (size_t)l * W_LAYER;
        const float* w_in = a.in[3] + (size_t)l * DM * DIN;
        if (r < I_P) { const int kb = r / 40, nb = r % 40, tile = nb >> 3, r8 = nb & 7, bj = r8 >> 2, wc = r8 & 3; int col;
            if (tile < 2) col = (4 * tile + wc) * 64 + 32 * bj;
            else if (tile < 4) col = 768 + (4 * (tile - 2) + wc) * 64 + 32 * bj;
            else if (wc < 2) col = 512 + wc * 64 + 32 * bj;
            else col = 1280 + (wc - 2) * 64 + 32 * bj;
            transpose_item<true>(w_in, DIN, col, kb * 64, wl + W_P, DM, nb * 32, scr, lane); continue; }
        r -= I_P;
        if (r < I_V) { const int kb = r / 8, nb = r % 8; const int col = nb < 4 ? 640 + 32 * nb : 1408 + 32 * (nb - 4);
            transpose_item<true>(w_in, DIN, col, kb * 64, wl + W_V, DM, nb * 32, scr, lane); continue; }
        r -= I_V;
        if (r < I_O) { const int kb = r / 32, nb = r % 32;
            transpose_item<false>(a.in[4] + (size_t)l * DM * DM, DM, nb * 32, kb * 64, wl + W_O, DM, nb * 32, scr, lane); continue; }
        r -= I_O;
        if (r < I_GU) { const int kb = r / 176, nb = r % 176, pn = nb >> 3, r8 = nb & 7;
            const float* src = (r8 < 4 ? a.in[10] : a.in[11]) + (size_t)l * DM * DFF;
            transpose_item<true>(src, DFF, 128 * pn + 32 * (r8 & 3), kb * 64, wl + W_GU, DM, nb * 32, scr, lane); continue; }
        r -= I_GU;
        { const int kb = r / 32, nb = r % 32;
            transpose_item<false>(a.in[12] + (size_t)l * DFF * DM, DM, nb * 32, kb * 64, wl + W_D, DFF, nb * 32, scr, lane); }
    }
    bf16* XB = (bf16*)(ws + WS_XB);
    for (int row = gw; row < MTOT; row += ngw) {
        const float* src = row < MHALF ? a.in[0] + (size_t)row * DM : a.in[1] + (size_t)(row - MHALF) * DM;
        const f32x4* xr = (const f32x4*)src + lane; v2u* ob = (v2u*)(XB + (size_t)row * DM) + lane;
#pragma unroll
        for (int j = 0; j < 4; ++j) { const f32x4 v = xr[64 * j]; v2u w; w.x = pkh(v[0], v[1]); w.y = pkh(v[2], v[3]); ob[64 * j] = w; }
    }
    const int gt = gw * 64 + lane, ngt = ngw * 64;
    float* rope = (float*)(ws + WS_ROPE);
    for (int i = gt; i < 128 * 16; i += ngt) { const int pos = i >> 4, j = i & 15;
        const float inv = powf(10000.0f, -(float)(2 * j) / 32.0f); const float ang = (float)pos * inv;
        rope[2 * i] = cosf(ang); rope[2 * i + 1] = sinf(ang); }
    float* lutg = (float*)(ws + WS_LUT);
    for (int i = gt; i < 8 * 452; i += ngt) { const int h = i / 452, idx = i % 452; float v = -1e30f; const int rel = idx - 224;
        if (rel >= -128 && rel <= 128) { const int n = rel < 0 ? -rel : rel; int bucket = rel > 0 ? 16 : 0;
            int large = 8 + (n >= 12) + (n >= 16) + (n >= 23) + (n >= 32) + (n >= 46) + (n >= 64) + (n >= 91); large = large > 15 ? 15 : large;
            bucket += n < 8 ? n : large; v = a.in[2][bucket * 8 + h] * LOG2E_F; }
        lutg[i] = v; }
}

__device__ __forceinline__ f32x4 bf4(v2u m) { f32x4 f; f[0] = __builtin_bit_cast(float, m.x << 16); f[1] = __builtin_bit_cast(float, m.x & 0xffff0000u); f[2] = __builtin_bit_cast(float, m.y << 16); f[3] = __builtin_bit_cast(float, m.y & 0xffff0000u); return f; }
__device__ __forceinline__ f32x4 h4(v2u m) { const h16x4 h = __builtin_bit_cast(h16x4, m); return __builtin_convertvector(h, f32x4); }
template <bool FINAL>
__device__ __forceinline__ void ln_phase(float* OUT, const bf16* MXlo, const bf16* MXhi, bf16* XB, const float* __restrict__ g, const float* __restrict__ b, int gw, int ngw, int lane) {
    constexpr int R = 4;
    for (int row0 = gw; row0 < MTOT; row0 += R * ngw) {
        f32x4 v[R][4];
#pragma unroll
        for (int r = 0; r < R; ++r) { const int row = row0 + r * ngw; if (row < MTOT) {
            const v2u* xr = (const v2u*)(XB + (size_t)row * DM) + lane; const v2u* mr = (const v2u*)((row < MHALF ? MXlo : MXhi) + (size_t)row * DM) + lane;
#pragma unroll
            for (int j = 0; j < 4; ++j) v[r][j] = h4(xr[64 * j]) * ALPHA_DN + bf4(mr[64 * j]); } }
#pragma unroll
        for (int r = 0; r < R; ++r) { const int row = row0 + r * ngw; if (row < MTOT) {
            f32x4* orow = (f32x4*)(OUT + (size_t)row * DM) + lane; v2u* ob = (v2u*)(XB + (size_t)row * DM) + lane;
            float s = 0.f;
#pragma unroll
            for (int j = 0; j < 4; ++j) s += (v[r][j][0] + v[r][j][1]) + (v[r][j][2] + v[r][j][3]);
            const float mean = wave_sum(s) * (1.f / DM); float s2 = 0.f;
#pragma unroll
            for (int j = 0; j < 4; ++j) { v[r][j] = v[r][j] - mean; s2 += (v[r][j][0] * v[r][j][0] + v[r][j][1] * v[r][j][1]) + (v[r][j][2] * v[r][j][2] + v[r][j][3] * v[r][j][3]); }
            const float rstd = 1.f / sqrtf(wave_sum(s2) * (1.f / DM) + 1e-5f);
#pragma unroll
            for (int j = 0; j < 4; ++j) { const f32x4 y = v[r][j] * rstd * ((const f32x4*)g)[lane + 64 * j] + ((const f32x4*)b)[lane + 64 * j];
                if (FINAL) orow[64 * j] = y; else { v2u w; w.x = pkh(y[0], y[1]); w.y = pkh(y[2], y[3]); ob[64 * j] = w; } } } }
    }
}

typedef const __attribute__((address_space(4))) Args* CArgs;
__device__ __forceinline__ CArgs argp() { CArgs p = (CArgs)__builtin_amdgcn_kernarg_segment_ptr(); asm volatile("" : "+s"(p)); return p; }
struct Ids { int lane, wave, G, bx, vcu, gw, ngw; };
__device__ __forceinline__ Ids ids() { Ids r; int tid_ = threadIdx.x; asm volatile("" : "+v"(tid_)); r.lane = tid_ & 63; r.wave = __builtin_amdgcn_readfirstlane(tid_ >> 6);
    int g_ = gridDim.x, b_ = blockIdx.x; asm volatile("" : "+s"(g_), "+s"(b_)); r.G = g_; r.bx = b_; r.vcu = (g_ % 8 == 0) ? (b_ % 8) * (g_ / 8) + b_ / 8 : b_; r.gw = r.vcu * NWAVES + r.wave; r.ngw = g_ * NWAVES; return r; }

__global__ void __launch_bounds__(NWAVES * 64, 2) mega_fwd(Args a_unused) {
    extern __shared__ __attribute__((aligned(16))) unsigned char lds_raw[];
    LAS unsigned char* lds = (LAS unsigned char*)lds_raw;
    cg::grid_group grid = cg::this_grid();
    volatile LAS unsigned* bst = (volatile LAS unsigned*)(lds + 131072);
    if (threadIdx.x < 2) bst[threadIdx.x] = 0u;
    __syncthreads();
    (void)xcd_barrier_post((unsigned*)(argp()->ws + WS_BAR), bst);
    const int ph_lo = argp()->ph_lo, ph_hi = argp()->ph_hi;
    int ph = 0;
#define PH_ON (ph >= ph_lo && ph < ph_hi)
#define PH_END do { if (ph >= ph_lo && ph + 1 < ph_hi) { if (ph == 0) grid.sync(); else { XcdBarrier xb_; xb_.bar = (unsigned*)(argp()->ws + WS_BAR); xb_.x = xb_xcc_id(); xb_.st = bst; xcd_barrier(xb_); } } ++ph; } while (0)

    if (PH_ON) {
#pragma unroll 1
        for (int rep_ = 0; rep_ < DUP_PRO; ++rep_) { const Ids I = ids(); prologue(argp(), lds, I.gw, I.ngw, I.wave, I.lane); } }
    PH_END;
#pragma unroll 1
    for (int l = 0; l < DEPTH; ++l) {
        if (PH_ON) {
#pragma unroll 1
            for (int rep_ = 0; rep_ < DUP_P1; ++rep_) {
            const Ids I = ids(); CArgs ap = argp(); unsigned char* ws = ap->ws;
            const bf16* wl = (const bf16*)(ws + WS_W) + (size_t)l * W_LAYER; bf16* XB = (bf16*)(ws + WS_XB);
            { const f32x4* rsrc = (const f32x4*)(ws + WS_ROPE); LAS f32x4* rdst = (LAS f32x4*)(lds + LDS_ROPE);
              for (int i = threadIdx.x; i < 1024; i += NWAVES * 64) rdst[i] = rsrc[i];
              __syncthreads(); }
            { pg8::Gemm g{XB, wl + W_P, MTOT, NPROJ, DM}; pg8::StaticOrder S; S.init(MTOT, NPROJ, I.G, I.bx);
              pg8::EpiProj E{(bf16*)(ws + WS_PROJ), ap->in[6] + l * 64, ap->in[7] + l * 64, (const LAS float*)(lds + LDS_ROPE)};
              pg8::gemm_phase<pg8::EpiProj, pg8::StaticOrder, true, true, true>(lds, g, S, E); }
            { pg8::Gemm g{wl + W_V, XB, 256, MTOT, DM}; pg8::StaticOrder S; S.init(256, MTOT, I.G, I.bx);
              pg8::EpiVT E{(bf16*)(ws + WS_VT)};
              pg8::gemm_phase<pg8::EpiVT, pg8::StaticOrder, true, true, true>(lds, g, S, E); }
            }
        }
        PH_END;
        if (PH_ON) {
            const Ids I = ids(); CArgs ap = argp(); unsigned char* ws = ap->ws;
            const bf16* PROJ = (const bf16*)(ws + WS_PROJ); const bf16* VT = (const bf16*)(ws + WS_VT); bf16* AO = (bf16*)ap->out;   const float* lutg = (const float*)(ws + WS_LUT);
            const float* sinkp = ap->in[5] + l * 8;
            float gq = fabsf(ap->in[6][l * 64 + I.lane]), gk = fabsf(ap->in[7][l * 64 + I.lane]);
#pragma unroll
            for (int o_ = 1; o_ < 64; o_ <<= 1) { gq = fmaxf(gq, __shfl_xor(gq, o_)); gk = fmaxf(gk, __shfl_xor(gk, o_)); }
            const float bound2 = 64.0f * QSCALE_F * gq * gk * 1.01f;
            if (bound2 <= 100.0f) {
#pragma unroll 1
            for (int rep_ = 0; rep_ < DUP_ATT; ++rep_)
#pragma unroll 1
            for (int u = I.vcu; u < 4096; u += I.G) {
                const int kind = u >> 10, idx = u & 1023; const bool sample = kind & 1, win = kind >= 2;
                const int S = sample ? 8192 : 4096, nqb = S >> 8, per = 4 * nqb;
                const int bk = idx / per, rem = idx % per, b = bk >> 1, kvh = bk & 1, hq = kvh * 4 + rem / nqb, qb = rem % nqb;
                const int rowbase = (sample ? MHALF : 0) + b * S;
                if (win) att::attn_win(lds, PROJ, VT, AO, rowbase, S, kvh, rem * 64, lutg, sinkp);
                else att::attn_global(lds, PROJ, VT, AO, rowbase, S, hq, qb * 256, bound2);
            }
            } else {
#pragma unroll 1
            for (int u = I.vcu; u < 4096; u += I.G) {
                const int kind = u >> 10, idx = u & 1023; const bool sample = kind & 1, win = kind >= 2;
                const int S = sample ? 8192 : 4096, nqb = S >> 8, per = 4 * nqb;
                const int bk = idx / per, rem = idx % per, b = bk >> 1, kvh = bk & 1, hq = kvh * 4 + rem / nqb, qb = rem % nqb;
                const int rowbase = (sample ? MHALF : 0) + b * S;
                if (win) att::attn_win(lds, PROJ, VT, AO, rowbase, S, kvh, rem * 64, lutg, sinkp);
                else att::attn_unit<0>(lds, PROJ, VT, AO, rowbase, S, hq, qb * 256, lutg, bound2);
            }
            }
        }
        PH_END;
        if (PH_ON) {
            const Ids I = ids(); CArgs ap = argp(); unsigned char* ws = ap->ws;
            const bf16* wl = (const bf16*)(ws + WS_W) + (size_t)l * W_LAYER;
            pg8::Gemm g{(const bf16*)ap->out, wl + W_O, MTOT, DM, DM}; pg8::StaticOrder S; S.init(MTOT, DM, I.G, I.bx);
            pg8::EpiBf16 E{(bf16*)(ws + WS_PROJ), DM};
#pragma unroll 1
            for (int rep_ = 0; rep_ < DUP_OP; ++rep_)
            pg8::gemm_phase<pg8::EpiBf16, pg8::StaticOrder, true, true>(lds, g, S, E);
        }
        PH_END;
        if (PH_ON) { const Ids I = ids(); CArgs ap = argp(); const bf16* mx = (const bf16*)(ap->ws + WS_PROJ);
            ln_phase<false>(ap->out, mx, mx, (bf16*)(ap->ws + WS_XB), ap->in[8] + l * DM, ap->in[9] + l * DM, I.gw, I.ngw, I.lane); }
        PH_END;
#pragma unroll 1
        for (int half = 0; half < 2; ++half) {
            if (PH_ON) {
                const Ids I = ids(); CArgs ap = argp(); unsigned char* ws = ap->ws;
                const bf16* wl = (const bf16*)(ws + WS_W) + (size_t)l * W_LAYER;
                pg8::Gemm g{(const bf16*)(ws + WS_XB) + (size_t)half * MHALF * DM, wl + W_GU, MHALF, 2 * DFF, DM}; pg8::StaticOrder S; S.init(MHALF, 2 * DFF, I.G, I.bx);
                pg8::EpiSwiGLU E{(bf16*)(ws + WS_H), DFF};
#pragma unroll 1
                for (int rep_ = 0; rep_ < DUP_FFN1; ++rep_)
                pg8::gemm_phase<pg8::EpiSwiGLU, pg8::StaticOrder, true, true, true>(lds, g, S, E);
            }
            PH_END;
            if (PH_ON) {
                const Ids I = ids(); CArgs ap = argp(); unsigned char* ws = ap->ws;
                const bf16* wl = (const bf16*)(ws + WS_W) + (size_t)l * W_LAYER;
                pg8::Gemm g{(const bf16*)(ws + WS_H), wl + W_D, MHALF, DM, DFF}; pg8::StaticOrder S; S.init(MHALF, DM, I.G, I.bx);
                pg8::EpiBf16 E{half == 0 ? (bf16*)(ws + WS_MX0) : (l < DEPTH - 1 ? (bf16*)((char*)ap->out + 128 * MiB) : (bf16*)(ws + WS_W)), DM};
#pragma unroll 1
                for (int rep_ = 0; rep_ < DUP_DN; ++rep_)
                pg8::gemm_phase<pg8::EpiBf16, pg8::StaticOrder, true, true>(lds, g, S, E);
            }
            PH_END;
        }
        if (PH_ON) { const Ids I = ids(); CArgs ap = argp(); const bf16* mlo = (const bf16*)(ap->ws + WS_MX0); bf16* xb = (bf16*)(ap->ws + WS_XB);
            const bf16* mhi = (l < DEPTH - 1 ? (const bf16*)((const char*)ap->out + 128 * MiB) : (const bf16*)(ap->ws + WS_W)) - (size_t)MHALF * DM;
            if (l == DEPTH - 1) ln_phase<true>(ap->out, mlo, mhi, xb, ap->in[13] + l * DM, ap->in[14] + l * DM, I.gw, I.ngw, I.lane);
            else ln_phase<false>(ap->out, mlo, mhi, xb, ap->in[13] + l * DM, ap->in[14] + l * DM, I.gw, I.ngw, I.lane); }
        PH_END;
    }
}
constexpr int N_PHASES = 1 + DEPTH * 9;

#ifndef MK_MULTI
#define MK_MULTI 0
#endif
extern "C" void kernel_launch(void* const* d_in, const int* in_sizes, int n_in, void* d_out, int out_size, void* d_ws, size_t ws_size, hipStream_t stream) {
    static int grid = 0;
    if (grid == 0) {
        if (n_in != 15 || out_size != MTOT * DM || ws_size < WS_END) { fprintf(stderr, "kernel_launch: unexpected shapes: n_in %d out %d ws %zu (need %zu)\n", n_in, out_size, ws_size, (size_t)WS_END); grid = -1; return; }
        int dev = 0, cus = 0, per_cu = 0;
        hipGetDevice(&dev); hipDeviceGetAttribute(&cus, hipDeviceAttributeMultiprocessorCount, dev);
        if (hipFuncSetAttribute((const void*)mega_fwd, hipFuncAttributeMaxDynamicSharedMemorySize, LDS_BYTES) != hipSuccess) { fprintf(stderr, "kernel_launch: hipFuncSetAttribute failed\n"); grid = -1; return; }
        if (hipOccupancyMaxActiveBlocksPerMultiprocessor(&per_cu, (const void*)mega_fwd, NWAVES * 64, LDS_BYTES) != hipSuccess || per_cu < 1) { fprintf(stderr, "kernel_launch: occupancy query gave %d\n", per_cu); per_cu = 1; }
        (void)hipGetLastError();
        grid = cus * per_cu;
        fprintf(stderr, "kernel_launch: grid %d (cus %d x %d), ws %zu\n", grid, cus, per_cu, ws_size);
    }
    if (grid < 0) return;
    if (hipMemsetAsync((char*)d_ws + WS_BAR, 0, 16384, stream) != hipSuccess) { fprintf(stderr, "kernel_launch: memset failed\n"); return; }
    Args a{};
    for (int i = 0; i < 15; ++i) a.in[i] = (const float*)d_in[i];
    a.out = (float*)d_out; a.ws = (unsigned char*)d_ws;
#if MK_MULTI
    for (int p = 0; p < N_PHASES; ++p) { a.ph_lo = p; a.ph_hi = p + 1; hipLaunchKernelGGL(mega_fwd, dim3(grid), dim3(NWAVES * 64), LDS_BYTES, stream, a); }
#else
    a.ph_lo = 0; a.ph_hi = N_PHASES;
    void* args[] = {&a};
    hipError_t e = hipLaunchCooperativeKernel((const void*)mega_fwd, dim3(grid), dim3(NWAVES * 64), args, LDS_BYTES, stream);
    if (e != hipSuccess) fprintf(stderr, "cooperative launch failed: %s (grid %d)\n", hipGetErrorString(e), grid);
#endif
}
```

```cpp
#include <hip/hip_runtime.h>
#include <hip/hip_cooperative_groups.h>
#include <cstdio>
#include <cstdint>
namespace cg = cooperative_groups;
#define ALPHA_DN 1.681792830507429f
#define LOG2E_F 1.4426950408889634f
#define QSCALE_F (0.125f * 1.4426950408889634f)
namespace pg8 {
#define PG8_LAS __attribute__((address_space(3)))
typedef unsigned short bf16_t;
typedef short bf16x8 __attribute__((ext_vector_type(8)));
typedef float f32x4 __attribute__((ext_vector_type(4)));
typedef unsigned u32x4 __attribute__((ext_vector_type(4)));
constexpr int BM = 256, BK = 64, HALF = 128, HTB = HALF * BK * 2  , STAGE_BYTES = 8 * HTB, NXCD = 8, WGM = 8;

__host__ __device__ __forceinline__ int lds_byte(int r, int c) { const int st = (r >> 4) * 2 + (c >> 5), rr = r & 15, cc = c & 31, ob = rr * 64 + cc * 2; return st * 1024 + (ob ^ (((ob >> 9) & 1) << 5)); }
__host__ __device__ __forceinline__ void stage_rc(int b, int& R, int& C) { const int st = b / 1024, sb = b % 1024, swz = sb ^ (((sb >> 9) & 1) << 5); R = (st >> 1) * 16 + swz / 64; C = (st & 1) * 32 + (swz % 64) / 2; }
__host__ __device__ __forceinline__ int perm32(int rho) { const int n = rho >> 4, i = rho & 15; return 8 * (i >> 2) + 4 * n + (i & 3); }

struct Unit { int pm, pn; };
struct Gemm { const bf16_t* A; const bf16_t* Bt; int M, N, K; };

struct StaticOrder {
    int nM, nN, nwg, G, c;
    __host__ __device__ void init(int M, int N, int G_, int c_) { nM = M / BM; nN = N / BM; nwg = nM * nN; G = G_; c = c_; }
    __host__ __device__ bool next(int i, Unit& u) const {
        const long L = (long)i * G + c; if (L >= nwg) return false;
        int wgid = (int)L; { const int q = nwg / NXCD, r = nwg % NXCD, xcd = wgid % NXCD, off = wgid / NXCD; wgid = (xcd < r ? xcd * (q + 1) : r * (q + 1) + (xcd - r) * q) + off; }
        const int nig = WGM * nN, gid = wgid / nig, fm = gid * WGM, gsz = (nM - fm) < WGM ? (nM - fm) : WGM;
        u.pm = fm + ((wgid % nig) % gsz); u.pn = (wgid % nig) / gsz; return true;
    }
    __device__ __forceinline__ void a_ready(const Unit&) const {}
    __device__ __forceinline__ void done(const Unit&) const {}
};

__device__ __forceinline__ unsigned cvt_pk_bf16(float lo, float hi) { unsigned r; asm volatile("v_cvt_pk_bf16_f32 %0, %1, %2" : "=v"(r) : "v"(lo), "v"(hi)); return r; }
struct EpiBf16 {
    static constexpr bool PERM = true, AFTER_DRAIN = false;
    bf16_t* O; int ldc;
    __device__ __forceinline__ void operator()(const f32x4 (&acc)[2][2][4][2], const Unit& u, int wr, int wc, int fr, int fq) const {
        const int row0 = u.pm * BM + wr * 64 + fr; const int col0 = u.pn * BM + wc * 32 + 8 * fq;
#pragma unroll
        for (int ai = 0; ai < 2; ++ai)
#pragma unroll
            for (int m = 0; m < 4; ++m) { bf16_t* rowp = O + (size_t)(row0 + ai * HALF + m * 16) * ldc + col0;
#pragma unroll
                for (int bj = 0; bj < 2; ++bj) { const f32x4 v0 = acc[ai][bj][m][0], v1 = acc[ai][bj][m][1];
                    u32x4 w; w.x = cvt_pk_bf16(v0[0], v0[1]); w.y = cvt_pk_bf16(v0[2], v0[3]); w.z = cvt_pk_bf16(v1[0], v1[1]); w.w = cvt_pk_bf16(v1[2], v1[3]);
                    *(u32x4*)(rowp + bj * HALF) = w; } }
    }
};
struct EpiVT {
    static constexpr bool PERM = true, AFTER_DRAIN = false;
    bf16_t* O;
    __device__ __forceinline__ void operator()(const f32x4 (&acc)[2][2][4][2], const Unit& u, int wr, int wc, int fr, int fq) const {
        const int row0 = wr * 64 + fr; const int col0 = u.pn * BM + wc * 32 + 8 * fq;
#pragma unroll
        for (int bj = 0; bj < 2; ++bj) { const int tok = col0 + bj * HALF; bf16_t* tp = O + (size_t)(tok >> 6) * (256 * 64) + (tok & 63);
#pragma unroll
            for (int ai = 0; ai < 2; ++ai)
#pragma unroll
                for (int m = 0; m < 4; ++m) { const f32x4 v0 = acc[ai][bj][m][0], v1 = acc[ai][bj][m][1];
                    u32x4 w; w.x = cvt_pk_bf16(v0[0], v0[1]); w.y = cvt_pk_bf16(v0[2], v0[3]); w.z = cvt_pk_bf16(v1[0], v1[1]); w.w = cvt_pk_bf16(v1[2], v1[3]);
                    *(u32x4*)(tp + (row0 + ai * HALF + m * 16) * 64) = w; } }
    }
};
struct EpiSwiGLU {
    static constexpr bool PERM = true, AFTER_DRAIN = false;
    bf16_t* O; int ldc;
    __device__ __forceinline__ void operator()(const f32x4 (&acc)[2][2][4][2], const Unit& u, int wr, int wc, int fr, int fq) const {
        const int row0 = u.pm * BM + wr * 64 + fr; const int col0 = u.pn * HALF + wc * 32 + 8 * fq;
#pragma unroll
        for (int ai = 0; ai < 2; ++ai)
#pragma unroll
            for (int m = 0; m < 4; ++m) { bf16_t* rowp = O + (size_t)(row0 + ai * HALF + m * 16) * ldc + col0;
                float h[8];
#pragma unroll
                for (int n = 0; n < 2; ++n)
#pragma unroll
                    for (int j = 0; j < 4; ++j) { const float g = acc[ai][0][m][n][j], up = acc[ai][1][m][n][j];
                        const float e = __builtin_amdgcn_exp2f(-g * LOG2E_F); h[n * 4 + j] = g * __builtin_amdgcn_rcpf(1.0f + e) * up; }
                u32x4 w; w.x = cvt_pk_bf16(h[0], h[1]); w.y = cvt_pk_bf16(h[2], h[3]); w.z = cvt_pk_bf16(h[4], h[5]); w.w = cvt_pk_bf16(h[6], h[7]);
                *(u32x4*)rowp = w; }
    }
};
struct EpiProj {
    static constexpr bool PERM = true, AFTER_DRAIN = false;
    bf16_t* O; const float* qg; const float* kg; const PG8_LAS float* rope;
    __device__ __forceinline__ void operator()(const f32x4 (&acc)[2][2][4][2], const Unit& u, int wr, int wc, int fr, int fq) const {
        const int pn = u.pn; int ocol; const float* g = nullptr; float sc = 1.f;
        if (pn < 2) { ocol = (4 * pn + wc) * 64; sc = QSCALE_F; }
        else if (pn < 4) { ocol = 512 + (4 * (pn - 2) + wc) * 64; g = qg; sc = QSCALE_F; }
        else if (wc < 2) { ocol = 1024 + wc * 64; }
        else { ocol = 1152 + (wc - 2) * 64; g = kg; }
        const int row0 = u.pm * BM + wr * 64 + fr;
        if (g == nullptr) {
#pragma unroll
            for (int ai = 0; ai < 2; ++ai)
#pragma unroll
                for (int m = 0; m < 4; ++m) { bf16_t* rowp = O + (size_t)(row0 + ai * HALF + m * 16) * 1280 + ocol + 8 * fq;
#pragma unroll
                    for (int bj = 0; bj < 2; ++bj) { const f32x4 v0 = acc[ai][bj][m][0] * sc, v1 = acc[ai][bj][m][1] * sc;
                        u32x4 w; w.x = cvt_pk_bf16(v0[0], v0[1]); w.y = cvt_pk_bf16(v0[2], v0[3]); w.z = cvt_pk_bf16(v1[0], v1[1]); w.w = cvt_pk_bf16(v1[2], v1[3]);
                        *(u32x4*)(rowp + bj * 32) = w; } }
        } else {
            f32x4 gv[2][2];
#pragma unroll
            for (int bj = 0; bj < 2; ++bj)
#pragma unroll
                for (int n = 0; n < 2; ++n) gv[bj][n] = *(const f32x4*)(g + 32 * bj + 8 * fq + 4 * n) * sc;
#pragma unroll
            for (int ai = 0; ai < 2; ++ai)
#pragma unroll
                for (int m = 0; m < 4; ++m) { const int row = row0 + ai * HALF + m * 16; bf16_t* rowp = O + (size_t)row * 1280 + ocol + 8 * fq;
                    float ss = 0.f;
#pragma unroll
                    for (int bj = 0; bj < 2; ++bj)
#pragma unroll
                        for (int n = 0; n < 2; ++n) { const f32x4 v = acc[ai][bj][m][n]; ss += (v[0] * v[0] + v[1] * v[1]) + (v[2] * v[2] + v[3] * v[3]); }
                    ss += __shfl_xor(ss, 16); ss += __shfl_xor(ss, 32);
                    const float rinv = __builtin_amdgcn_rsqf(ss * (1.0f / 64.0f) + 1e-6f);
                    const int spos = row & (row < 32768 ? 4095 : 8191);
#pragma unroll
                    for (int bj = 0; bj < 2; ++bj) { const int pos = bj == 0 ? (spos >> 6) : (spos & 63); f32x4 o[2];
#pragma unroll
                        for (int n = 0; n < 2; ++n) { const f32x4 cs = *(const PG8_LAS f32x4*)(rope + (pos * 16 + 4 * fq + 2 * n) * 2);
                            const f32x4 y = acc[ai][bj][m][n] * rinv * gv[bj][n];
                            o[n][0] = y[0] * cs[0] - y[1] * cs[1]; o[n][1] = y[0] * cs[1] + y[1] * cs[0];
                            o[n][2] = y[2] * cs[2] - y[3] * cs[3]; o[n][3] = y[2] * cs[3] + y[3] * cs[2]; }
                        u32x4 w; w.x = cvt_pk_bf16(o[0][0], o[0][1]); w.y = cvt_pk_bf16(o[0][2], o[0][3]); w.z = cvt_pk_bf16(o[1][0], o[1][1]); w.w = cvt_pk_bf16(o[1][2], o[1][3]);
                        *(u32x4*)(rowp + bj * 32) = w; } }
        }
    }
};
typedef _Float16 f16x8 __attribute__((ext_vector_type(8)));
template <class Epi, class Sched, bool ALIGN_EPI = false, bool SP2 = false, bool F16 = false>
__device__ __forceinline__ void gemm_phase(PG8_LAS unsigned char* lds, const Gemm g, const Sched& S, const Epi& E) {
    int tid_ = threadIdx.x; asm volatile("" : "+v"(tid_));
    const int tid = tid_, wid = __builtin_amdgcn_readfirstlane(tid >> 6), lane = tid & 63, wr = wid >> 2, wc = wid & 3, fr = lane & 15, fq = lane >> 4;
    const int K = g.K, nt = K / BK;
    unsigned voffA[2], voffB[2];
#pragma unroll
    for (int i = 0; i < 2; ++i) { int R, C; stage_rc(tid * 16 + i * 8192, R, C); const int Rb = Epi::PERM ? ((R & ~31) + perm32(R & 31)) : R;
        voffA[i] = (unsigned)(R * K + C) * 2u; voffB[i] = (unsigned)(Rb * K + C) * 2u; }
    const size_t kstep = (size_t)(BK * 2);
    const size_t hstep = (size_t)HALF * K * 2;
    const size_t tstep = 2 * hstep;
    const unsigned ldsw = (unsigned)wid * 1024u;
    const int aoff = lds_byte(wr * 64 + fr, fq * 8), boff = lds_byte(wc * 32 + fr, fq * 8);
#define PG8_SA(b, h) (((b) * 2 + (h)) * HTB)
#define PG8_SB(b, h) ((4 + (b) * 2 + (h)) * HTB)
#define PG8_STAGE(bufoff, gbase, voff) do { _Pragma("unroll") for (int _i = 0; _i < 2; ++_i) \
        __builtin_amdgcn_global_load_lds((const unsigned*)((const char*)(gbase) + (voff)[_i]), (PG8_LAS unsigned*)(lds + (bufoff) + ldsw + _i * 8192), 16, 0, 0); } while (0)
#define PG8_LDA(dst, b, h) do { _Pragma("unroll") for (int m = 0; m < 4; ++m) _Pragma("unroll") for (int k = 0; k < 2; ++k) dst[m][k] = *(const PG8_LAS bf16x8*)(lds + PG8_SA(b, h) + aoff + m * 2048 + k * 1024); } while (0)
#define PG8_LDB(dst, b, h) do { _Pragma("unroll") for (int n = 0; n < 2; ++n) _Pragma("unroll") for (int k = 0; k < 2; ++k) dst[n][k] = *(const PG8_LAS bf16x8*)(lds + PG8_SB(b, h) + boff + n * 2048 + k * 1024); } while (0)
#define PG8_MMA(ai, bj, At, Bt) do { __builtin_amdgcn_s_setprio(1); _Pragma("unroll") for (int m = 0; m < 4; ++m) _Pragma("unroll") for (int n = 0; n < 2; ++n) _Pragma("unroll") for (int k = 0; k < 2; ++k) \
        acc[ai][bj][m][n] = F16 ? __builtin_amdgcn_mfma_f32_16x16x32_f16(__builtin_bit_cast(f16x8, Bt[n][k]), __builtin_bit_cast(f16x8, At[m][k]), acc[ai][bj][m][n], 0, 0, 0) \
                                : __builtin_amdgcn_mfma_f32_16x16x32_bf16(Bt[n][k], At[m][k], acc[ai][bj][m][n], 0, 0, 0); __builtin_amdgcn_s_setprio(0); } while (0)
#define PG8_WAIT_V(n) asm volatile("s_waitcnt vmcnt(" #n ")" ::: "memory")
#define PG8_WAIT_L(n) asm volatile("s_waitcnt lgkmcnt(" #n ")" ::: "memory")
#define PG8_BAR __builtin_amdgcn_s_barrier()
#define PG8_SCHED __builtin_amdgcn_sched_barrier(0)
    Unit cur, nxt; int ui = 0;
    if (!S.next(0, cur)) return;
    f32x4 acc[2][2][4][2];
#pragma unroll
    for (int a = 0; a < 2; ++a)
#pragma unroll
        for (int b = 0; b < 2; ++b)
#pragma unroll
            for (int m = 0; m < 4; ++m)
#pragma unroll
                for (int n = 0; n < 2; ++n) acc[a][b][m][n] = (f32x4){0.f, 0.f, 0.f, 0.f};
    bf16x8 At[4][2], B0[2][2], B1[2][2];
    const char* cA = (const char*)g.A + (size_t)cur.pm * tstep; const char* cB = (const char*)g.Bt + (size_t)cur.pn * tstep;
    S.a_ready(cur);
    if constexpr (SP2) {
        PG8_STAGE(PG8_SB(0, 0), cB, voffB); PG8_STAGE(PG8_SB(0, 1), cB + hstep, voffB); PG8_STAGE(PG8_SA(0, 0), cA, voffA); PG8_STAGE(PG8_SA(0, 1), cA + hstep, voffA);
        if (wr == 1) PG8_BAR;
        PG8_WAIT_V(2); PG8_BAR;
        PG8_STAGE(PG8_SB(1, 0), cB + kstep, voffB); PG8_STAGE(PG8_SA(1, 0), cA + kstep, voffA); PG8_STAGE(PG8_SB(1, 1), cB + hstep + kstep, voffB);
        PG8_WAIT_V(6); PG8_BAR;
    } else {
        PG8_STAGE(PG8_SB(0, 0), cB, voffB); PG8_STAGE(PG8_SA(0, 0), cA, voffA); PG8_STAGE(PG8_SB(0, 1), cB + hstep, voffB); PG8_STAGE(PG8_SA(0, 1), cA + hstep, voffA);
        if (wr == 1) PG8_BAR;
        PG8_WAIT_V(4); PG8_BAR;
        PG8_STAGE(PG8_SB(1, 0), cB + kstep, voffB); PG8_STAGE(PG8_SA(1, 0), cA + kstep, voffA); PG8_STAGE(PG8_SB(1, 1), cB + hstep + kstep, voffB);
        PG8_WAIT_V(6); PG8_BAR;
    }
    for (;;) {
        const bool has_next = S.next(ui + 1, nxt);
        const char* nA = has_next ? (const char*)g.A + (size_t)nxt.pm * tstep : cA; const char* nB = has_next ? (const char*)g.Bt + (size_t)nxt.pn * tstep : cB;
        for (int t = 0; t < nt; t += 2) {
            const bool last = (t == nt - 2);
            const char* a1 = cA + (size_t)(t + 1) * kstep;
            const char* a2 = last ? nA : cA + (size_t)(t + 2) * kstep; const char* b2 = last ? nB : cB + (size_t)(t + 2) * kstep;
            const char* a3 = a2 + kstep; const char* b3 = b2 + kstep;
            if (last && has_next) S.a_ready(nxt);
            if constexpr (SP2) {
            PG8_LDB(B0, 0, 0); PG8_LDB(B1, 0, 1); PG8_SCHED; PG8_LDA(At, 0, 0); PG8_STAGE(PG8_SA(1, 1), a1 + hstep, voffA);
            PG8_WAIT_V(8); PG8_WAIT_L(0); PG8_BAR; PG8_MMA(0, 0, At, B0); PG8_MMA(0, 1, At, B1); PG8_BAR; PG8_SCHED;
            PG8_LDA(At, 0, 1); PG8_STAGE(PG8_SB(0, 0), b2, voffB); PG8_STAGE(PG8_SB(0, 1), b2 + hstep, voffB); PG8_STAGE(PG8_SA(0, 0), a2, voffA);
            PG8_WAIT_V(8); PG8_WAIT_L(0); PG8_BAR; PG8_MMA(1, 0, At, B0); PG8_MMA(1, 1, At, B1); PG8_BAR; PG8_SCHED;
            PG8_LDB(B0, 1, 0); PG8_LDB(B1, 1, 1); PG8_SCHED; PG8_LDA(At, 1, 0); PG8_STAGE(PG8_SA(0, 1), a2 + hstep, voffA);
            PG8_WAIT_V(8); PG8_WAIT_L(0); PG8_BAR; PG8_MMA(0, 0, At, B0); PG8_MMA(0, 1, At, B1); PG8_BAR; PG8_SCHED;
            PG8_LDA(At, 1, 1); PG8_STAGE(PG8_SB(1, 0), b3, voffB); PG8_STAGE(PG8_SB(1, 1), b3 + hstep, voffB); PG8_STAGE(PG8_SA(1, 0), a3, voffA);
            PG8_WAIT_V(8); PG8_WAIT_L(0); PG8_BAR; PG8_MMA(1, 0, At, B0); PG8_MMA(1, 1, At, B1); PG8_BAR; PG8_SCHED;
            } else {
            PG8_LDB(B0, 0, 0); PG8_SCHED; PG8_LDA(At, 0, 0); PG8_STAGE(PG8_SA(1, 1), a1 + hstep, voffA);
            PG8_WAIT_L(8); PG8_BAR; PG8_WAIT_L(0); PG8_MMA(0, 0, At, B0); PG8_BAR; PG8_SCHED;
            PG8_LDB(B1, 0, 1); PG8_STAGE(PG8_SB(0, 0), b2, voffB);
            PG8_BAR; PG8_WAIT_L(0); PG8_MMA(0, 1, At, B1); PG8_BAR;
            PG8_LDA(At, 0, 1); PG8_STAGE(PG8_SA(0, 0), a2, voffA);
            PG8_BAR; PG8_WAIT_L(0); PG8_MMA(1, 0, At, B0); PG8_BAR; PG8_SCHED;
            PG8_STAGE(PG8_SB(0, 1), b2 + hstep, voffB);
            PG8_WAIT_V(6); PG8_BAR; PG8_MMA(1, 1, At, B1); PG8_BAR;
            PG8_LDB(B0, 1, 0); PG8_SCHED; PG8_LDA(At, 1, 0); PG8_STAGE(PG8_SA(0, 1), a2 + hstep, voffA);
            PG8_WAIT_L(8); PG8_BAR; PG8_WAIT_L(0); PG8_MMA(0, 0, At, B0); PG8_BAR; PG8_SCHED;
            PG8_LDB(B1, 1, 1); PG8_STAGE(PG8_SB(1, 0), b3, voffB);
            PG8_BAR; PG8_WAIT_L(0); PG8_MMA(0, 1, At, B1); PG8_BAR;
            PG8_LDA(At, 1, 1); PG8_STAGE(PG8_SA(1, 0), a3, voffA);
            PG8_BAR; PG8_WAIT_L(0); PG8_MMA(1, 0, At, B0); PG8_BAR; PG8_SCHED;
            PG8_STAGE(PG8_SB(1, 1), b3 + hstep, voffB);
            PG8_WAIT_V(6); PG8_BAR; PG8_MMA(1, 1, At, B1); PG8_BAR;
            }
        }
        if constexpr (ALIGN_EPI) { if (wr == 0) PG8_BAR; }
        if constexpr (!Epi::AFTER_DRAIN) { E(acc, cur, wr, wc, fr, fq); S.done(cur); }
        if (!has_next) break;
#pragma unroll
        for (int a = 0; a < 2; ++a)
#pragma unroll
            for (int b = 0; b < 2; ++b)
#pragma unroll
                for (int m = 0; m < 4; ++m)
#pragma unroll
                    for (int n = 0; n < 2; ++n) acc[a][b][m][n] = (f32x4){0.f, 0.f, 0.f, 0.f};
        cur = nxt; cA = nA; cB = nB; ++ui;
        if constexpr (ALIGN_EPI) { if (wr == 1) PG8_BAR; }
    }
    PG8_WAIT_V(0);
    if constexpr (!ALIGN_EPI) { if (wr == 0) PG8_BAR; }
    PG8_BAR;
    if constexpr (Epi::AFTER_DRAIN) { E.fused(acc, cur, wr, wc, fr, fq, lds, wid, lane); S.done(cur); }
#undef PG8_SA
#undef PG8_SB
#undef PG8_STAGE
#undef PG8_LDA
#undef PG8_LDB
#undef PG8_MMA
#undef PG8_WAIT_V
#undef PG8_WAIT_L
#undef PG8_BAR
#undef PG8_SCHED
}
}
namespace att {
#define LAS __attribute__((address_space(3)))
typedef unsigned short bf16_t;
typedef short bf16x8 __attribute__((ext_vector_type(8)));
typedef float f32x16 __attribute__((ext_vector_type(16)));
typedef float f32x4 __attribute__((ext_vector_type(4)));
typedef unsigned u32x4 __attribute__((ext_vector_type(4)));
typedef unsigned u32x2 __attribute__((ext_vector_type(2)));
typedef float f32x2_t __attribute__((ext_vector_type(2))); typedef __bf16 bf16x2_t __attribute__((ext_vector_type(2)));
__device__ __forceinline__ unsigned cvtpk(float lo, float hi) { f32x2_t v = {lo, hi}; bf16x2_t b = __builtin_convertvector(v, bf16x2_t); return __builtin_bit_cast(unsigned, b); }
constexpr int KP = 144;
constexpr int TB = 64 * KP;
constexpr int OFF_K = 0, OFF_V = 2 * TB, OFF_LUT = 4 * TB, ATT_LDS = 4 * TB + 4 * 452 * 4;
constexpr int PITCH_P = 1280, PITCH_VT = 65536, PITCH_O = 1024;

template <int WIN>
__device__ __forceinline__ void attn_unit(LAS unsigned char* lds, const bf16_t* __restrict__ PROJ, const bf16_t* __restrict__ VT, bf16_t* __restrict__ AO,
                                          int rowbase, int S, int hq, int q0, const float* __restrict__ lut_g, float sink2  ) {
    int tid_ = threadIdx.x; asm volatile("" : "+v"(tid_));
    const int tid = tid_, lane = tid & 63, r32 = lane & 31, hi = lane >> 5; const int wid = __builtin_amdgcn_readfirstlane(tid >> 6);
    const int kvh = hq >> 2;
    const int qcol = WIN ? hq * 64 : 512 + hq * 64;
    const int kcol = WIN ? 1024 + kvh * 64 : 1152 + kvh * 64;
    const int vrow0 = WIN ? kvh * 64 : 128 + kvh * 64;
    const int ocol = WIN ? hq * 64 : 512 + hq * 64;
    int kt0 = 0, kt1 = S >> 6;
    if (WIN) { const int lo = q0 - 128, hi_ = q0 + 256 + 128; kt0 = (lo < 0 ? 0 : lo) >> 6; kt1 = (hi_ > S ? S : hi_) >> 6; }
    const int krow = tid >> 3, kch = tid & 7;
    const bf16_t* ksrc = PROJ + (size_t)(rowbase + krow) * PITCH_P + kcol + kch * 8;
    const bf16_t* vsrc = VT + ((size_t)(rowbase >> 6) * 256 + vrow0 + krow) * 64 + kch * 8;
    const int kdst = OFF_K + krow * KP + kch * 16;
    const int vdst = OFF_V + krow * KP + (kch >> 1) * 32 + (kch & 1) * 8;
    LAS float* lut = (LAS float*)(lds + OFF_LUT);
    if (WIN) { if (tid < 257) lut[tid] = lut_g[tid]; }
    const int qw = q0 + wid * 32;
    const bf16_t* qp = PROJ + (size_t)(rowbase + qw + r32) * PITCH_P + qcol + hi * 8;
    bf16x8 qf[4];
#pragma unroll
    for (int ds = 0; ds < 4; ++ds) qf[ds] = *(const bf16x8*)(qp + ds * 16);
    u32x4 kreg = *(const u32x4*)(ksrc + (size_t)kt0 * 64 * PITCH_P);
    u32x4 vreg = *(const u32x4*)(vsrc + (size_t)kt0 * 16384);
    *(LAS u32x4*)(lds + kdst) = kreg;
    *(LAS u32x2*)(lds + vdst) = (u32x2){vreg.x, vreg.y}; *(LAS u32x2*)(lds + vdst + 16) = (u32x2){vreg.z, vreg.w};
    if (kt0 + 1 < kt1) { kreg = *(const u32x4*)(ksrc + (size_t)(kt0 + 1) * 64 * PITCH_P); vreg = *(const u32x4*)(vsrc + (size_t)(kt0 + 1) * 16384); }
    float m = WIN ? sink2 : 0.f, l = WIN ? 0.5f : 0.f;
    f32x16 negb; { const float nb_ = WIN ? 0.f : -sink2;
#pragma unroll
      for (int r = 0; r < 16; ++r) negb[r] = nb_; }
    f32x16 o0 = {}, o1 = {};
    __syncthreads();
    for (int t = kt0; t < kt1; ++t) {
        const int cur = (t - kt0) & 1;
        if (t + 1 < kt1) {
            const int nb = (cur ^ 1) * TB;
            *(LAS u32x4*)(lds + nb + kdst) = kreg;
            *(LAS u32x2*)(lds + nb + vdst) = (u32x2){vreg.x, vreg.y}; *(LAS u32x2*)(lds + nb + vdst + 16) = (u32x2){vreg.z, vreg.w};
            if (t + 2 < kt1) { kreg = *(const u32x4*)(ksrc + (size_t)(t + 2) * 64 * PITCH_P); vreg = *(const u32x4*)(vsrc + (size_t)(t + 2) * 16384); }
        }
        const int k0 = t * 64;
        bool active = true;
        if (WIN) active = (k0 + 63 >= qw - 128) && (k0 <= qw + 31 + 128);
        if (active) {
            const LAS unsigned char* kb = lds + OFF_K + cur * TB + r32 * KP + hi * 16;
            f32x16 sA = negb, sB = negb;
#pragma unroll
            for (int ds = 0; ds < 4; ++ds) {
                const bf16x8 ka = *(const LAS bf16x8*)(kb + ds * 32);
                const bf16x8 kb2 = *(const LAS bf16x8*)(kb + 32 * KP + ds * 32);
                sA = __builtin_amdgcn_mfma_f32_32x32x16_bf16(ka, qf[ds], sA, 0, 0, 0);
                sB = __builtin_amdgcn_mfma_f32_32x32x16_bf16(kb2, qf[ds], sB, 0, 0, 0);
            }
            if (WIN) {
                const int qpos = qw + r32;
#pragma unroll
                for (int r = 0; r < 16; ++r) {
                    const int key = k0 + (r & 3) + 8 * (r >> 2) + 4 * hi;
                    int relA = key - qpos + 128, relB = relA + 32;
                    const bool vA = (relA >= 0) && (relA <= 256), vB = (relB >= 0) && (relB <= 256);
                    relA = relA < 0 ? 0 : (relA > 256 ? 256 : relA); relB = relB < 0 ? 0 : (relB > 256 ? 256 : relB);
                    sA[r] = vA ? sA[r] + lut[relA] : -1e30f; sB[r] = vB ? sB[r] + lut[relB] : -1e30f;
                }
            }
            if (WIN) {
            float mx = fmaxf(sA[0], sB[0]);
#pragma unroll
            for (int r = 1; r < 16; ++r) mx = fmaxf(mx, fmaxf(sA[r], sB[r]));
            mx = fmaxf(mx, __shfl_xor(mx, 32));
            const float mn = fmaxf(m, mx);
            const float alpha = __builtin_amdgcn_exp2f(m - mn);
            m = mn;
            float ps = 0.f;
#pragma unroll
            for (int r = 0; r < 16; ++r) { sA[r] = __builtin_amdgcn_exp2f(sA[r] - mn); sB[r] = __builtin_amdgcn_exp2f(sB[r] - mn); ps += sA[r] + sB[r]; }
            l = l * alpha + ps;
#pragma unroll
            for (int r = 0; r < 16; ++r) { o0[r] *= alpha; o1[r] *= alpha; }
            } else {
                float ps = 0.f;
#pragma unroll
                for (int r = 0; r < 16; ++r) { sA[r] = __builtin_amdgcn_exp2f(sA[r]); sB[r] = __builtin_amdgcn_exp2f(sB[r]); ps += sA[r] + sB[r]; }
                l += ps;
            }
            bf16x8 pk[4];
            { u32x4 w;
              w.x = cvtpk(sA[0], sA[1]); w.y = cvtpk(sA[2], sA[3]); w.z = cvtpk(sA[4], sA[5]); w.w = cvtpk(sA[6], sA[7]); pk[0] = __builtin_bit_cast(bf16x8, w);
              w.x = cvtpk(sA[8], sA[9]); w.y = cvtpk(sA[10], sA[11]); w.z = cvtpk(sA[12], sA[13]); w.w = cvtpk(sA[14], sA[15]); pk[1] = __builtin_bit_cast(bf16x8, w);
              w.x = cvtpk(sB[0], sB[1]); w.y = cvtpk(sB[2], sB[3]); w.z = cvtpk(sB[4], sB[5]); w.w = cvtpk(sB[6], sB[7]); pk[2] = __builtin_bit_cast(bf16x8, w);
              w.x = cvtpk(sB[8], sB[9]); w.y = cvtpk(sB[10], sB[11]); w.z = cvtpk(sB[12], sB[13]); w.w = cvtpk(sB[14], sB[15]); pk[3] = __builtin_bit_cast(bf16x8, w); }
            const LAS unsigned char* vb = lds + OFF_V + cur * TB + r32 * KP + hi * 16;
#pragma unroll
            for (int s = 0; s < 4; ++s) {
                const bf16x8 va = *(const LAS bf16x8*)(vb + s * 32);
                const bf16x8 vb2 = *(const LAS bf16x8*)(vb + 32 * KP + s * 32);
                o0 = __builtin_amdgcn_mfma_f32_32x32x16_bf16(va, pk[s], o0, 0, 0, 0);
                o1 = __builtin_amdgcn_mfma_f32_32x32x16_bf16(vb2, pk[s], o1, 0, 0, 0);
            }
        }
        asm volatile("s_waitcnt lgkmcnt(0)\n\ts_barrier" ::: "memory");
    }
    const float lt = l + __shfl_xor(l, 32);
    const float inv = 1.0f / lt;
    bf16_t* op = AO + (size_t)(rowbase + qw + r32) * PITCH_O + ocol + 4 * hi;
#pragma unroll
    for (int g4 = 0; g4 < 4; ++g4) {
        u32x2 w0, w1;
        w0.x = cvtpk(o0[4 * g4] * inv, o0[4 * g4 + 1] * inv); w0.y = cvtpk(o0[4 * g4 + 2] * inv, o0[4 * g4 + 3] * inv);
        w1.x = cvtpk(o1[4 * g4] * inv, o1[4 * g4 + 1] * inv); w1.y = cvtpk(o1[4 * g4 + 2] * inv, o1[4 * g4 + 3] * inv);
        *(u32x2*)(op + 8 * g4) = w0; *(u32x2*)(op + 32 + 8 * g4) = w1;
    }
}

#define ATT_BAR() asm volatile("s_waitcnt lgkmcnt(0)\n\ts_barrier" ::: "memory")
__device__ __forceinline__ void attn_global(LAS unsigned char* lds, const bf16_t* __restrict__ PROJ, const bf16_t* __restrict__ VT, bf16_t* __restrict__ AO,
                                            int rowbase, int S, int hq, int q0, float bound2) {
    int tid_ = threadIdx.x; asm volatile("" : "+v"(tid_));
    const int tid = tid_, lane = tid & 63, r32 = lane & 31, hi = lane >> 5; const int wid = __builtin_amdgcn_readfirstlane(tid >> 6);
    const int kvh = hq >> 2, qcol = 512 + hq * 64, kcol = 1152 + kvh * 64, vrow0 = 128 + kvh * 64, ocol = 512 + hq * 64;
    const int T = S >> 6;
    const int krow = tid >> 3, kch = tid & 7;
    const bf16_t* ksrc = PROJ + (size_t)(rowbase + krow) * PITCH_P + kcol + kch * 8;
    const bf16_t* vsrc = VT + ((size_t)(rowbase >> 6) * 256 + vrow0 + krow) * 64 + kch * 8;
    constexpr int RK = 0, RV = 4 * TB;
    const int kdst = RK + krow * KP + kch * 16;
    const int vdst = RV + krow * KP + (kch >> 1) * 32 + (kch & 1) * 8;
    const int qw = q0 + wid * 32;
    const bf16_t* qp = PROJ + (size_t)(rowbase + qw + r32) * PITCH_P + qcol + hi * 8;
    bf16x8 qf[4];
#pragma unroll
    for (int ds = 0; ds < 4; ++ds) qf[ds] = *(const bf16x8*)(qp + ds * 16);
#define LDK(t) (*(const u32x4*)(ksrc + (size_t)(t) * 64 * PITCH_P))
#define LDV(t) (*(const u32x4*)(vsrc + (size_t)(t) * 16384))
#define STK(slot, reg) (*(LAS u32x4*)(lds + (slot) * TB + kdst) = (reg))
#define STV(slot, reg) do { *(LAS u32x2*)(lds + (slot) * TB + vdst) = (u32x2){(reg).x, (reg).y}; *(LAS u32x2*)(lds + (slot) * TB + vdst + 16) = (u32x2){(reg).z, (reg).w}; } while (0)
    u32x4 kra, krb, vra, vrb;
    kra = LDK(0); krb = LDK(1); vra = LDV(0); vrb = LDV(1);
    STK(0, kra); STK(1, krb); STV(0, vra); STV(1, vrb);
    kra = LDK(2); STK(2, kra);
    kra = LDK(3); krb = LDK(4); vra = LDV(2); vrb = LDV(3);
    const f32x16 zero16 = {};
    f32x16 lacc = {};
    const bf16x8 ones8 = {0x3F80, 0x3F80, 0x3F80, 0x3F80, 0x3F80, 0x3F80, 0x3F80, 0x3F80};
    f32x16 o0 = {}, o1 = {}, sA, sB, nA, nB;
    const LAS unsigned char* kfb = lds + RK + r32 * KP + hi * 16;
    const LAS unsigned char* vfb = lds + RV + r32 * KP + hi * 16;
#define QK_TILE(SA, SB, slot) do { _Pragma("unroll") for (int ds = 0; ds < 4; ++ds) { \
        const bf16x8 ka_ = *(const LAS bf16x8*)(kfb + (slot) * TB + ds * 32), kb_ = *(const LAS bf16x8*)(kfb + (slot) * TB + 32 * KP + ds * 32); \
        SA = __builtin_amdgcn_mfma_f32_32x32x16_bf16(ka_, qf[ds], ds == 0 ? zero16 : SA, 0, 0, 0); \
        SB = __builtin_amdgcn_mfma_f32_32x32x16_bf16(kb_, qf[ds], ds == 0 ? zero16 : SB, 0, 0, 0); } } while (0)
    ATT_BAR();
    QK_TILE(sA, sB, 0);
    ATT_BAR();
#define ATT_HALF(SA, SB, NA, NB, ks, vs, DOQK) do { \
        if (DOQK) QK_TILE(NA, NB, ks); \
        _Pragma("unroll") for (int r = 0; r < 16; ++r) { SA[r] = __builtin_amdgcn_exp2f(SA[r]); SB[r] = __builtin_amdgcn_exp2f(SB[r]); } \
        bf16x8 pk_[4]; { u32x4 w_; \
          w_.x = cvtpk(SA[0], SA[1]); w_.y = cvtpk(SA[2], SA[3]); w_.z = cvtpk(SA[4], SA[5]); w_.w = cvtpk(SA[6], SA[7]); pk_[0] = __builtin_bit_cast(bf16x8, w_); \
          w_.x = cvtpk(SA[8], SA[9]); w_.y = cvtpk(SA[10], SA[11]); w_.z = cvtpk(SA[12], SA[13]); w_.w = cvtpk(SA[14], SA[15]); pk_[1] = __builtin_bit_cast(bf16x8, w_); \
          w_.x = cvtpk(SB[0], SB[1]); w_.y = cvtpk(SB[2], SB[3]); w_.z = cvtpk(SB[4], SB[5]); w_.w = cvtpk(SB[6], SB[7]); pk_[2] = __builtin_bit_cast(bf16x8, w_); \
          w_.x = cvtpk(SB[8], SB[9]); w_.y = cvtpk(SB[10], SB[11]); w_.z = cvtpk(SB[12], SB[13]); w_.w = cvtpk(SB[14], SB[15]); pk_[3] = __builtin_bit_cast(bf16x8, w_); } \
        _Pragma("unroll") for (int s = 0; s < 4; ++s) { \
            const bf16x8 va_ = *(const LAS bf16x8*)(vfb + (vs) * TB + s * 32), vb_ = *(const LAS bf16x8*)(vfb + (vs) * TB + 32 * KP + s * 32); \
            o0 = __builtin_amdgcn_mfma_f32_32x32x16_bf16(va_, pk_[s], o0, 0, 0, 0); \
            o1 = __builtin_amdgcn_mfma_f32_32x32x16_bf16(vb_, pk_[s], o1, 0, 0, 0); \
            lacc = __builtin_amdgcn_mfma_f32_32x32x16_bf16(ones8, pk_[s], lacc, 0, 0, 0); } } while (0)
#define ATT_DSTEP(t, p, FULL) do { \
        if (FULL || (t) + 3 < T) STK(((p) + 3) & 3, kra); \
        if (FULL || (t) + 4 < T) STK((p), krb); \
        if (FULL || (t) + 2 < T) STV(((p) + 2) & 3, vra); \
        if (FULL || (t) + 3 < T) STV(((p) + 3) & 3, vrb); \
        if (FULL || (t) + 5 < T) kra = LDK((t) + 5); \
        if (FULL || (t) + 6 < T) krb = LDK((t) + 6); \
        if (FULL || (t) + 4 < T) vra = LDV((t) + 4); \
        if (FULL || (t) + 5 < T) vrb = LDV((t) + 5); \
        ATT_HALF(sA, sB, nA, nB, ((p) + 1) & 3, (p), (FULL || (t) + 1 < T)); \
        ATT_HALF(nA, nB, sA, sB, ((p) + 2) & 3, ((p) + 1) & 3, (FULL || (t) + 2 < T)); \
        ATT_BAR(); } while (0)
    int t = 0;
#pragma unroll 1
    for (; t + 10 < T; t += 4) { ATT_DSTEP(t, 0, true); ATT_DSTEP(t + 2, 2, true); }
#pragma unroll 1
    for (; t < T; t += 4) { ATT_DSTEP(t, 0, false); ATT_DSTEP(t + 2, 2, false); }
#undef ATT_DSTEP
#undef ATT_HALF
#undef QK_TILE
#undef LDK
#undef LDV
#undef STK
#undef STV
    const float inv = 1.0f / lacc[0];
    bf16_t* op = AO + (size_t)(rowbase + qw + r32) * PITCH_O + ocol + 4 * hi;
#pragma unroll
    for (int g4 = 0; g4 < 4; ++g4) {
        u32x2 w0, w1;
        w0.x = cvtpk(o0[4 * g4] * inv, o0[4 * g4 + 1] * inv); w0.y = cvtpk(o0[4 * g4 + 2] * inv, o0[4 * g4 + 3] * inv);
        w1.x = cvtpk(o1[4 * g4] * inv, o1[4 * g4 + 1] * inv); w1.y = cvtpk(o1[4 * g4 + 2] * inv, o1[4 * g4 + 3] * inv);
        *(u32x2*)(op + 8 * g4) = w0; *(u32x2*)(op + 32 + 8 * g4) = w1;
    }
}

__device__ __forceinline__ void attn_win(LAS unsigned char* lds, const bf16_t* __restrict__ PROJ, const bf16_t* __restrict__ VT, bf16_t* __restrict__ AO,
                                         int rowbase, int S, int kvh, int q0, const float* __restrict__ lut_g  , const float* __restrict__ sinkp  ) {
    int tid_ = threadIdx.x; asm volatile("" : "+v"(tid_));
    const int tid = tid_, lane = tid & 63, r32 = lane & 31, hi = lane >> 5; const int wid = __builtin_amdgcn_readfirstlane(tid >> 6);
    const int hq = kvh * 4 + (wid >> 1);
    const int qcol = hq * 64, kcol = 1024 + kvh * 64, vrow0 = kvh * 64, ocol = hq * 64;
    const int lo = q0 - 128, hi_ = q0 + 64 + 128;
    const int kt0 = (lo < 0 ? 0 : lo) >> 6, kt1 = (hi_ > S ? S : hi_) >> 6;
    const int krow = tid >> 3, kch = tid & 7;
    const bf16_t* ksrc = PROJ + (size_t)(rowbase + krow) * PITCH_P + kcol + kch * 8;
    const bf16_t* vsrc = VT + ((size_t)(rowbase >> 6) * 256 + vrow0 + krow) * 64 + kch * 8;
    const int kdst = OFF_K + krow * KP + kch * 16;
    const int vdst = OFF_V + krow * KP + (kch >> 1) * 32 + (kch & 1) * 8;
    LAS float* lut4 = (LAS float*)(lds + OFF_LUT);
    for (int i = tid; i < 4 * 452; i += 512) lut4[i] = lut_g[kvh * 4 * 452 + i];
    const LAS float* lut = lut4 + (wid >> 1) * 452;
    const float sink2 = sinkp[hq] * LOG2E_F;
    const int qw = q0 + (wid & 1) * 32;
    const bf16_t* qp = PROJ + (size_t)(rowbase + qw + r32) * PITCH_P + qcol + hi * 8;
    bf16x8 qf[4];
#pragma unroll
    for (int ds = 0; ds < 4; ++ds) qf[ds] = *(const bf16x8*)(qp + ds * 16);
    u32x4 kreg = *(const u32x4*)(ksrc + (size_t)kt0 * 64 * PITCH_P);
    u32x4 vreg = *(const u32x4*)(vsrc + (size_t)kt0 * 16384);
    *(LAS u32x4*)(lds + kdst) = kreg;
    *(LAS u32x2*)(lds + vdst) = (u32x2){vreg.x, vreg.y}; *(LAS u32x2*)(lds + vdst + 16) = (u32x2){vreg.z, vreg.w};
    if (kt0 + 1 < kt1) { kreg = *(const u32x4*)(ksrc + (size_t)(kt0 + 1) * 64 * PITCH_P); vreg = *(const u32x4*)(vsrc + (size_t)(kt0 + 1) * 16384); }
    float m = sink2, l = 0.5f;
    f32x16 o0 = {}, o1 = {};
    asm volatile("s_waitcnt lgkmcnt(0)\n\ts_barrier" ::: "memory");
    for (int t = kt0; t < kt1; ++t) {
        const int cur = (t - kt0) & 1;
        if (t + 1 < kt1) {
            const int nb = (cur ^ 1) * TB;
            *(LAS u32x4*)(lds + nb + kdst) = kreg;
            *(LAS u32x2*)(lds + nb + vdst) = (u32x2){vreg.x, vreg.y}; *(LAS u32x2*)(lds + nb + vdst + 16) = (u32x2){vreg.z, vreg.w};
            if (t + 2 < kt1) { kreg = *(const u32x4*)(ksrc + (size_t)(t + 2) * 64 * PITCH_P); vreg = *(const u32x4*)(vsrc + (size_t)(t + 2) * 16384); }
        }
        const int k0 = t * 64;
        if ((k0 + 63 >= qw - 128) && (k0 <= qw + 31 + 128)) {
            const LAS unsigned char* kb = lds + OFF_K + cur * TB + r32 * KP + hi * 16;
            f32x16 sA = {}, sB = {};
#pragma unroll
            for (int ds = 0; ds < 4; ++ds) {
                const bf16x8 ka = *(const LAS bf16x8*)(kb + ds * 32);
                const bf16x8 kb2 = *(const LAS bf16x8*)(kb + 32 * KP + ds * 32);
                sA = __builtin_amdgcn_mfma_f32_32x32x16_bf16(ka, qf[ds], sA, 0, 0, 0);
                sB = __builtin_amdgcn_mfma_f32_32x32x16_bf16(kb2, qf[ds], sB, 0, 0, 0);
            }
            { const LAS float* lp = lut + (k0 - (qw + r32) + 224 + 4 * hi);
#pragma unroll
              for (int r = 0; r < 16; ++r) { sA[r] += lp[(r & 3) + 8 * (r >> 2)]; sB[r] += lp[32 + (r & 3) + 8 * (r >> 2)]; } }
            float mx = fmaxf(sA[0], sB[0]);
#pragma unroll
            for (int r = 1; r < 16; ++r) mx = fmaxf(mx, fmaxf(sA[r], sB[r]));
            mx = fmaxf(mx, __shfl_xor(mx, 32));
            const float mn = fmaxf(m, mx);
            const float alpha = __builtin_amdgcn_exp2f(m - mn);
            m = mn;
            float ps = 0.f;
#pragma unroll
            for (int r = 0; r < 16; ++r) { sA[r] = __builtin_amdgcn_exp2f(sA[r] - mn); sB[r] = __builtin_amdgcn_exp2f(sB[r] - mn); ps += sA[r] + sB[r]; }
            l = l * alpha + ps;
#pragma unroll
            for (int r = 0; r < 16; ++r) { o0[r] *= alpha; o1[r] *= alpha; }
            bf16x8 pk[4];
            { u32x4 w;
              w.x = cvtpk(sA[0], sA[1]); w.y = cvtpk(sA[2], sA[3]); w.z = cvtpk(sA[4], sA[5]); w.w = cvtpk(sA[6], sA[7]); pk[0] = __builtin_bit_cast(bf16x8, w);
              w.x = cvtpk(sA[8], sA[9]); w.y = cvtpk(sA[10], sA[11]); w.z = cvtpk(sA[12], sA[13]); w.w = cvtpk(sA[14], sA[15]); pk[1] = __builtin_bit_cast(bf16x8, w);
              w.x = cvtpk(sB[0], sB[1]); w.y = cvtpk(sB[2], sB[3]); w.z = cvtpk(sB[4], sB[5]); w.w = cvtpk(sB[6], sB[7]); pk[2] = __builtin_bit_cast(bf16x8, w);
              w.x = cvtpk(sB[8], sB[9]); w.y = cvtpk(sB[10], sB[11]); w.z = cvtpk(sB[12], sB[13]); w.w = cvtpk(sB[14], sB[15]); pk[3] = __builtin_bit_cast(bf16x8, w); }
            const LAS unsigned char* vb = lds + OFF_V + cur * TB + r32 * KP + hi * 16;
#pragma unroll
            for (int s = 0; s < 4; ++s) {
                const bf16x8 va = *(const LAS bf16x8*)(vb + s * 32);
                const bf16x8 vb2 = *(const LAS bf16x8*)(vb + 32 * KP + s * 32);
                o0 = __builtin_amdgcn_mfma_f32_32x32x16_bf16(va, pk[s], o0, 0, 0, 0);
                o1 = __builtin_amdgcn_mfma_f32_32x32x16_bf16(vb2, pk[s], o1, 0, 0, 0);
            }
        }
        asm volatile("s_waitcnt lgkmcnt(0)\n\ts_barrier" ::: "memory");
    }
    const float lt = l + __shfl_xor(l, 32);
    const float inv = 1.0f / lt;
    bf16_t* op = AO + (size_t)(rowbase + qw + r32) * PITCH_O + ocol + 4 * hi;
#pragma unroll
    for (int g4 = 0; g4 < 4; ++g4) {
        u32x2 w0, w1;
        w0.x = cvtpk(o0[4 * g4] * inv, o0[4 * g4 + 1] * inv); w0.y = cvtpk(o0[4 * g4 + 2] * inv, o0[4 * g4 + 3] * inv);
        w1.x = cvtpk(o1[4 * g4] * inv, o1[4 * g4 + 1] * inv); w1.y = cvtpk(o1[4 * g4 + 2] * inv, o1[4 * g4 + 3] * inv);
        *(u32x2*)(op + 8 * g4) = w0; *(u32x2*)(op + 32 + 8 * g4) = w1;
    }
}
}

typedef unsigned short bf16;
typedef unsigned v4u __attribute__((ext_vector_type(4)));
typedef unsigned v2u __attribute__((ext_vector_type(2)));
typedef float f32x4 __attribute__((ext_vector_type(4)));
constexpr int NWAVES = 8;
#ifndef DUP_ATT
#define DUP_ATT 1
#endif
#ifndef DUP_FFN1
#define DUP_FFN1 1
#endif
#ifndef DUP_LN
#define DUP_LN 1
#endif
#ifndef DUP_PRO
#define DUP_PRO 1
#endif
#ifndef DUP_P1
#define DUP_P1 1
#endif
#ifndef DUP_OP
#define DUP_OP 1
#endif
#ifndef DUP_DN
#define DUP_DN 1
#endif
constexpr int DM = 1024, DIN = 1536, DFF = 2816, DEPTH = 4, MTOT = 65536, MHALF = 32768, NPROJ = 1280;
constexpr size_t MiB = 1u << 20;
constexpr size_t WS_ROPE = 0;
constexpr size_t WS_LUT = 32768;
constexpr size_t WS_STATS = 256 * 1024;
constexpr size_t WS_W = 1 * MiB;
constexpr size_t W_P = 0, W_V = W_P + (size_t)1280 * 1024, W_O = W_V + (size_t)256 * 1024, W_GU = W_O + (size_t)1024 * 1024, W_D = W_GU + (size_t)5632 * 1024, W_LAYER = W_D + (size_t)1024 * 2816;
constexpr size_t WS_XB = 88 * MiB;
constexpr size_t WS_PROJ = 216 * MiB;
constexpr size_t WS_VT = 376 * MiB;
constexpr size_t WS_H = 216 * MiB;
constexpr size_t WS_MX0 = 408 * MiB;
constexpr size_t WS_END = 472 * MiB;
static_assert(W_LAYER * 2 * 3 >= (size_t)MHALF * DM * 2 && WS_W + W_LAYER * 2 * DEPTH <= WS_XB && WS_H + (size_t)MHALF * DFF * 2 <= WS_END, "ws map");
constexpr int LDS_ROPE = 131328;
constexpr int LDS_BYTES = 147968;

constexpr size_t WS_BAR = 65536;
#define XB_TMO      128
#define XB_XCNT(j)  (256  + 64 * (j))
#define XB_XSUB(j)  (1280 + 64 * (j))
#define XB_XGEN(j)  (2304 + 64 * (j))
#define XB_TOP      3328
#define XB_TOPGEN   3392
#define XCD_BAR_WORDS 3456
#define XB_SPIN_CAP (1u << 18)

__device__ __forceinline__ unsigned xb_ld(unsigned* p)              { return __hip_atomic_load(p, __ATOMIC_RELAXED, __HIP_MEMORY_SCOPE_AGENT); }
__device__ __forceinline__ unsigned xb_add(unsigned* p, unsigned v) { return __hip_atomic_fetch_add(p, v, __ATOMIC_RELAXED, __HIP_MEMORY_SCOPE_AGENT); }
__device__ __forceinline__ unsigned xb_xcc_id() { return (unsigned)__builtin_amdgcn_s_getreg((3 << 11) | 20) & 0xFu; }
#define XB_SPIN(cond, bar) do { unsigned _sp = 0; while (cond) { __builtin_amdgcn_s_sleep(1); \
    if ((++_sp & 255u) == 0u) { if (xb_ld(&(bar)[XB_TMO])) break; if (_sp > XB_SPIN_CAP) { atomicAdd(&(bar)[XB_TMO], 1u); break; } } } } while (0)

struct XcdBarrier {
    unsigned* bar; unsigned x;
    volatile LAS unsigned* st;
};

__device__ __forceinline__ XcdBarrier xcd_barrier_post(unsigned* bar, volatile LAS unsigned* st) {
    XcdBarrier b; b.bar = bar; b.x = xb_xcc_id(); b.st = st;
    if (threadIdx.x == 0) (void)xb_add(&bar[XB_XCNT(b.x)], 1u);
    return b;
}
__device__ __forceinline__ void xcd_barrier_complete(unsigned* bar, unsigned x, unsigned& nloc, unsigned& nx) {
    const unsigned G = gridDim.x * gridDim.y * gridDim.z;
    unsigned sum, cnt, mine, sp = 0u;
    for (;;) {
        sum = 0u; cnt = 0u; mine = 0u;
#pragma unroll
        for (unsigned j = 0; j < 16; ++j) { const unsigned c = xb_ld(&bar[XB_XCNT(j)]); sum += c; cnt += (c > 0u) ? 1u : 0u; mine = (j == x) ? c : mine; }
        if (sum == G) break;
        __builtin_amdgcn_s_sleep(1);
        if ((++sp & 255u) == 0u) { if (xb_ld(&bar[XB_TMO])) break; if (sp > XB_SPIN_CAP) { atomicAdd(&bar[XB_TMO], 1u); break; } }
    }
    nloc = mine > 0u ? mine : 1u; nx = cnt > 0u ? cnt : 1u;
}

__device__ __forceinline__ void xcd_barrier(const XcdBarrier& b) {
    asm volatile("s_waitcnt vmcnt(0)" ::: "memory");
    __syncthreads();
    if (threadIdx.x == 0) {
        unsigned* bar = b.bar;
        __builtin_amdgcn_s_waitcnt(0);
        unsigned nloc = b.st[0], nx = b.st[1];
        if (nloc == 0u) { xcd_barrier_complete(bar, b.x, nloc, nx); b.st[0] = nloc; b.st[1] = nx; }
        const unsigned old = xb_add(&bar[XB_XSUB(b.x)], 1u);
        const unsigned gen = old / nloc;
        if (old + 1u == (gen + 1u) * nloc) {
            __builtin_amdgcn_fence(__ATOMIC_RELEASE, "agent");
            asm volatile("s_waitcnt vmcnt(0)" ::: "memory");
            const unsigned og = xb_add(&bar[XB_TOP], 1u);
            const unsigned tg = og / nx;
            if (og + 1u == (tg + 1u) * nx) xb_add(&bar[XB_TOPGEN], 1u);
            else XB_SPIN(xb_ld(&bar[XB_TOPGEN]) == tg, bar);
            __builtin_amdgcn_fence(__ATOMIC_ACQUIRE, "agent");
            xb_add(&bar[XB_XGEN(b.x)], 1u);
            asm volatile("s_waitcnt vmcnt(0)" ::: "memory");
        } else {
            XB_SPIN(xb_ld(&bar[XB_XGEN(b.x)]) == gen, bar);
            __builtin_amdgcn_fence(__ATOMIC_ACQUIRE, "agent");
            asm volatile("s_waitcnt vmcnt(0)" ::: "memory");
        }
    }
    __syncthreads();
}

struct Args { const float* in[15]; float* out; unsigned char* ws; int ph_lo, ph_hi; };

__device__ __forceinline__ unsigned f2bf(float f) { unsigned u = __builtin_bit_cast(unsigned, f); return (u + 0x7fffu + ((u >> 16) & 1u)) >> 16; }
__device__ __forceinline__ unsigned pk2(float lo, float hi) { return f2bf(lo) | (f2bf(hi) << 16); }
typedef _Float16 h16x2 __attribute__((ext_vector_type(2))); typedef _Float16 h16x4 __attribute__((ext_vector_type(4))); typedef float f32x2p __attribute__((ext_vector_type(2)));
__device__ __forceinline__ unsigned pkh(float lo, float hi) { f32x2p v = {lo, hi}; return __builtin_bit_cast(unsigned, __builtin_convertvector(v, h16x2)); }
template <bool H> __device__ __forceinline__ unsigned pk16(float lo, float hi) { return H ? pkh(lo, hi) : pk2(lo, hi); }
__device__ __forceinline__ float wave_sum(float v) {
#pragma unroll
    for (int o = 1; o < 64; o <<= 1) v += __shfl_xor(v, o);
    return v;
}
template <bool H>
__device__ __forceinline__ void transpose_item(const float* __restrict__ W, int ldw, int col0, int k0, bf16* __restrict__ WT, int K, int n0, LAS float* scr, int lane) {
#pragma unroll 8
    for (int i = 0; i < 32; ++i) { const int kk = 2 * i + (lane >> 5); scr[kk * 33 + (lane & 31)] = W[(size_t)(k0 + kk) * ldw + col0 + (lane & 31)]; }
    asm volatile("s_waitcnt lgkmcnt(0)" ::: "memory");
    const int c = lane & 7;
#pragma unroll
    for (int j = 0; j < 4; ++j) { const int n = (lane >> 3) + 8 * j; const LAS float* s = scr + (8 * c) * 33 + n;
        v4u o; o.x = pk16<H>(s[0 * 33], s[1 * 33]); o.y = pk16<H>(s[2 * 33], s[3 * 33]); o.z = pk16<H>(s[4 * 33], s[5 * 33]); o.w = pk16<H>(s[6 * 33], s[7 * 33]);
        *(v4u*)(WT + (size_t)(n0 + n) * K + k0 + 8 * c) = o; }
    asm volatile("s_waitcnt lgkmcnt(0)" ::: "memory");
}

typedef const __attribute__((address_space(4))) Args* CArgsP;
__device__ __forceinline__ void prologue(CArgsP ap_, LAS unsigned char* lds, int gw, int ngw, int wave, int lane) {
    Args a;
#pragma unroll
    for (int i = 0; i < 15; ++i) a.in[i] = ap_->in[i];
    a.out = ap_->out; a.ws = ap_->ws; a.ph_lo = 0; a.ph_hi = 0;
    unsigned char* ws = a.ws;
    LAS float* scr = (LAS float*)(lds + wave * 16384);
    constexpr int I_P = 16 * 40, I_V = 16 * 8, I_O = 16 * 32, I_GU = 16 * 176, I_D = 44 * 32, I_LAYER = I_P + I_V + I_O + I_GU + I_D;
    for (int it = gw; it < I_LAYER * DEPTH; it += ngw) {
        const int l = it / I_LAYER; int r = it % I_LAYER;
        bf16* wl = (bf16*)(ws + WS_W) + (size_t)l * W_LAYER;
        const float* w_in = a.in[3] + (size_t)l * DM * DIN;
        if (r < I_P) { const int kb = r / 40, nb = r % 40, tile = nb >> 3, r8 = nb & 7, bj = r8 >> 2, wc = r8 & 3; int col;
            if (tile < 2) col = (4 * tile + wc) * 64 + 32 * bj;
            else if (tile < 4) col = 768 + (4 * (tile - 2) + wc) * 64 + 32 * bj;
            else if (wc < 2) col = 512 + wc * 64 + 32 * bj;
            else col = 1280 + (wc - 2) * 64 + 32 * bj;
            transpose_item<true>(w_in, DIN, col, kb * 64, wl + W_P, DM, nb * 32, scr, lane); continue; }
        r -= I_P;
        if (r < I_V) { const int kb = r / 8, nb = r % 8; const int col = nb < 4 ? 640 + 32 * nb : 1408 + 32 * (nb - 4);
            transpose_item<true>(w_in, DIN, col, kb * 64, wl + W_V, DM, nb * 32, scr, lane); continue; }
        r -= I_V;
        if (r < I_O) { const int kb = r / 32, nb = r % 32;
            transpose_item<false>(a.in[4] + (size_t)l * DM * DM, DM, nb * 32, kb * 64, wl + W_O, DM, nb * 32, scr, lane); continue; }
        r -= I_O;
        if (r < I_GU) { const int kb = r / 176, nb = r % 176, pn = nb >> 3, r8 = nb & 7;
            const float* src = (r8 < 4 ? a.in[10] : a.in[11]) + (size_t)l * DM * DFF;
            transpose_item<true>(src, DFF, 128 * pn + 32 * (r8 & 3), kb * 64, wl + W_GU, DM, nb * 32, scr, lane); continue; }
        r -= I_GU;
        { const int kb = r / 32, nb = r % 32;
            transpose_item<false>(a.in[12] + (size_t)l * DFF * DM, DM, nb * 32, kb * 64, wl + W_D, DFF, nb * 32, scr, lane); }
    }
    bf16* XB = (bf16*)(ws + WS_XB);
    for (int row = gw; row < MTOT; row += ngw) {
        const float* src = row < MHALF ? a.in[0] + (size_t)row * DM : a.in[1] + (size_t)(row - MHALF) * DM;
        const f32x4* xr = (const f32x4*)src + lane; v2u* ob = (v2u*)(XB + (size_t)row * DM) + lane;
#pragma unroll
        for (int j = 0; j < 4; ++j) { const f32x4 v = xr[64 * j]; v2u w; w.x = pkh(v[0], v[1]); w.y = pkh(v[2], v[3]); ob[64 * j] = w; }
    }
    const int gt = gw * 64 + lane, ngt = ngw * 64;
    float* rope = (float*)(ws + WS_ROPE);
    for (int i = gt; i < 128 * 16; i += ngt) { const int pos = i >> 4, j = i & 15;
        const float inv = powf(10000.0f, -(float)(2 * j) / 32.0f); const float ang = (float)pos * inv;
        rope[2 * i] = cosf(ang); rope[2 * i + 1] = sinf(ang); }
    float* lutg = (float*)(ws + WS_LUT);
    for (int i = gt; i < 8 * 452; i += ngt) { const int h = i / 452, idx = i % 452; float v = -1e30f; const int rel = idx - 224;
        if (rel >= -128 && rel <= 128) { const int n = rel < 0 ? -rel : rel; int bucket = rel > 0 ? 16 : 0;
            int large = 8 + (n >= 12) + (n >= 16) + (n >= 23) + (n >= 32) + (n >= 46) + (n >= 64) + (n >= 91); large = large > 15 ? 15 : large;
            bucket += n < 8 ? n : large; v = a.in[2][bucket * 8 + h] * LOG2E_F; }
        lutg[i] = v; }
}

__device__ __forceinline__ f32x4 bf4(v2u m) { f32x4 f; f[0] = __builtin_bit_cast(float, m.x << 16); f[1] = __builtin_bit_cast(float, m.x & 0xffff0000u); f[2] = __builtin_bit_cast(float, m.y << 16); f[3] = __builtin_bit_cast(float, m.y & 0xffff0000u); return f; }
__device__ __forceinline__ f32x4 h4(v2u m) { const h16x4 h = __builtin_bit_cast(h16x4, m); return __builtin_convertvector(h, f32x4); }
template <bool FINAL>
__device__ __forceinline__ void ln_phase(float* OUT, const bf16* MXlo, const bf16* MXhi, bf16* XB, const float* __restrict__ g, const float* __restrict__ b, int gw, int ngw, int lane) {
    constexpr int R = 4;
    for (int row0 = gw; row0 < MTOT; row0 += R * ngw) {
        f32x4 v[R][4];
#pragma unroll
        for (int r = 0; r < R; ++r) { const int row = row0 + r * ngw; if (row < MTOT) {
            const v2u* xr = (const v2u*)(XB + (size_t)row * DM) + lane; const v2u* mr = (const v2u*)((row < MHALF ? MXlo : MXhi) + (size_t)row * DM) + lane;
#pragma unroll
            for (int j = 0; j < 4; ++j) v[r][j] = h4(xr[64 * j]) * ALPHA_DN + bf4(mr[64 * j]); } }
#pragma unroll
        for (int r = 0; r < R; ++r) { const int row = row0 + r * ngw; if (row < MTOT) {
            f32x4* orow = (f32x4*)(OUT + (size_t)row * DM) + lane; v2u* ob = (v2u*)(XB + (size_t)row * DM) + lane;
            float s = 0.f;
#pragma unroll
            for (int j = 0; j < 4; ++j) s += (v[r][j][0] + v[r][j][1]) + (v[r][j][2] + v[r][j][3]);
            const float mean = wave_sum(s) * (1.f / DM); float s2 = 0.f;
#pragma unroll
            for (int j = 0; j < 4; ++j) { v[r][j] = v[r][j] - mean; s2 += (v[r][j][0] * v[r][j][0] + v[r][j][1] * v[r][j][1]) + (v[r][j][2] * v[r][j][2] + v[r][j][3] * v[r][j][3]); }
            const float rstd = 1.f / sqrtf(wave_sum(s2) * (1.f / DM) + 1e-5f);
#pragma unroll
            for (int j = 0; j < 4; ++j) { const f32x4 y = v[r][j] * rstd * ((const f32x4*)g)[lane + 64 * j] + ((const f32x4*)b)[lane + 64 * j];
                if (FINAL) orow[64 * j] = y; else { v2u w; w.x = pkh(y[0], y[1]); w.y = pkh(y[2], y[3]); ob[64 * j] = w; } } } }
    }
}

typedef const __attribute__((address_space(4))) Args* CArgs;
__device__ __forceinline__ CArgs argp() { CArgs p = (CArgs)__builtin_amdgcn_kernarg_segment_ptr(); asm volatile("" : "+s"(p)); return p; }
struct Ids { int lane, wave, G, bx, vcu, gw, ngw; };
__device__ __forceinline__ Ids ids0() { Ids r; int tid_ = threadIdx.x; asm volatile("" : "+v"(tid_)); r.lane = tid_ & 63; r.wave = __builtin_amdgcn_readfirstlane(tid_ >> 6);
    int g_ = gridDim.x, b_ = blockIdx.x; asm volatile("" : "+s"(g_), "+s"(b_)); r.G = g_; r.bx = b_; r.vcu = b_; r.gw = r.vcu * NWAVES + r.wave; r.ngw = g_ * NWAVES; return r; }
__device__ __forceinline__ Ids ids(volatile LAS unsigned* st) { Ids r; int tid_ = threadIdx.x; asm volatile("" : "+v"(tid_)); r.lane = tid_ & 63; r.wave = __builtin_amdgcn_readfirstlane(tid_ >> 6);
    int g_ = gridDim.x; asm volatile("" : "+s"(g_)); r.G = g_; r.vcu = __builtin_amdgcn_readfirstlane((int)st[4]); r.bx = __builtin_amdgcn_readfirstlane((int)st[5]); r.gw = r.vcu * NWAVES + r.wave; r.ngw = g_ * NWAVES; return r; }

__device__ __forceinline__ void place_workgroup(volatile LAS unsigned* st, unsigned* bar_) {
    if (threadIdx.x == 0) { const unsigned x_ = st[2], rank_ = st[3], per_ = gridDim.x / 8u; unsigned pre_ = 0u, xi_ = 0u, nx_ = 0u; bool eq_ = true;
        for (unsigned j = 0; j < 16u; ++j) { const unsigned c_ = xb_ld(&bar_[XB_XCNT(j)]); if (c_) { ++nx_; eq_ = eq_ && (c_ == per_); } if (j < x_) { pre_ += c_; xi_ += c_ ? 1u : 0u; } }
        const unsigned v_ = pre_ + rank_; st[4] = v_; st[5] = (eq_ && nx_ == 8u && gridDim.x % 8u == 0u) ? rank_ * 8u + xi_ : v_; }
    __syncthreads();
}
__global__ void __launch_bounds__(NWAVES * 64, 2) mega_fwd(Args a_unused) {
    extern __shared__ __attribute__((aligned(16))) unsigned char lds_raw[];
    LAS unsigned char* lds = (LAS unsigned char*)lds_raw;
    cg::grid_group grid = cg::this_grid();
    volatile LAS unsigned* bst = (volatile LAS unsigned*)(lds + 131072);
    if (threadIdx.x < 8) bst[threadIdx.x] = 0u;
    __syncthreads();
    if (threadIdx.x == 0) { unsigned* bar_ = (unsigned*)(argp()->ws + WS_BAR); const unsigned x_ = xb_xcc_id(); bst[2] = x_; bst[3] = xb_add(&bar_[XB_XCNT(x_)], 1u); }
    const int ph_lo = argp()->ph_lo, ph_hi = argp()->ph_hi;
    int ph = 0;
#define PH_ON (ph >= ph_lo && ph < ph_hi)
#define PH_END do { if (ph >= ph_lo && ph + 1 < ph_hi) { if (ph == 0) { grid.sync(); place_workgroup(bst, (unsigned*)(argp()->ws + WS_BAR)); } else { XcdBarrier xb_; xb_.bar = (unsigned*)(argp()->ws + WS_BAR); xb_.x = xb_xcc_id(); xb_.st = bst; xcd_barrier(xb_); } } ++ph; } while (0)

    if (PH_ON) {
#pragma unroll 1
        for (int rep_ = 0; rep_ < DUP_PRO; ++rep_) { const Ids I = ids0(); prologue(argp(), lds, I.gw, I.ngw, I.wave, I.lane); } }
    PH_END;
#pragma unroll 1
    for (int l = 0; l < DEPTH; ++l) {
        if (PH_ON) {
#pragma unroll 1
            for (int rep_ = 0; rep_ < DUP_P1; ++rep_) {
            const Ids I = ids(bst); CArgs ap = argp(); unsigned char* ws = ap->ws;
            const bf16* wl = (const bf16*)(ws + WS_W) + (size_t)l * W_LAYER; bf16* XB = (bf16*)(ws + WS_XB);
            { const f32x4* rsrc = (const f32x4*)(ws + WS_ROPE); LAS f32x4* rdst = (LAS f32x4*)(lds + LDS_ROPE);
              for (int i = threadIdx.x; i < 1024; i += NWAVES * 64) rdst[i] = rsrc[i];
              __syncthreads(); }
            { pg8::Gemm g{XB, wl + W_P, MTOT, NPROJ, DM}; pg8::StaticOrder S; S.init(MTOT, NPROJ, I.G, I.bx);
              pg8::EpiProj E{(bf16*)(ws + WS_PROJ), ap->in[6] + l * 64, ap->in[7] + l * 64, (const LAS float*)(lds + LDS_ROPE)};
              pg8::gemm_phase<pg8::EpiProj, pg8::StaticOrder, true, true, true>(lds, g, S, E); }
            { pg8::Gemm g{wl + W_V, XB, 256, MTOT, DM}; pg8::StaticOrder S; S.init(256, MTOT, I.G, I.bx);
              pg8::EpiVT E{(bf16*)(ws + WS_VT)};
              pg8::gemm_phase<pg8::EpiVT, pg8::StaticOrder, true, true, true>(lds, g, S, E); }
            }
        }
        PH_END;
        if (PH_ON) {
            const Ids I = ids(bst); CArgs ap = argp(); unsigned char* ws = ap->ws;
            const bf16* PROJ = (const bf16*)(ws + WS_PROJ); const bf16* VT = (const bf16*)(ws + WS_VT); bf16* AO = (bf16*)ap->out;   const float* lutg = (const float*)(ws + WS_LUT);
            const float* sinkp = ap->in[5] + l * 8;
            float gq = fabsf(ap->in[6][l * 64 + I.lane]), gk = fabsf(ap->in[7][l * 64 + I.lane]);
#pragma unroll
            for (int o_ = 1; o_ < 64; o_ <<= 1) { gq = fmaxf(gq, __shfl_xor(gq, o_)); gk = fmaxf(gk, __shfl_xor(gk, o_)); }
            const float bound2 = 64.0f * QSCALE_F * gq * gk * 1.01f;
            if (bound2 <= 100.0f) {
#pragma unroll 1
            for (int rep_ = 0; rep_ < DUP_ATT; ++rep_)
#pragma unroll 1
            for (int u = I.vcu; u < 4096; u += I.G) {
                const int kind = u >> 10, idx = u & 1023; const bool sample = kind & 1, win = kind >= 2;
                const int S = sample ? 8192 : 4096, nqb = S >> 8, per = 4 * nqb;
                const int bk = idx / per, rem = idx % per, b = bk >> 1, kvh = bk & 1, hq = kvh * 4 + rem / nqb, qb = rem % nqb;
                const int rowbase = (sample ? MHALF : 0) + b * S;
                if (win) att::attn_win(lds, PROJ, VT, AO, rowbase, S, kvh, rem * 64, lutg, sinkp);
                else att::attn_global(lds, PROJ, VT, AO, rowbase, S, hq, qb * 256, bound2);
            }
            } else {
#pragma unroll 1
            for (int u = I.vcu; u < 4096; u += I.G) {
                const int kind = u >> 10, idx = u & 1023; const bool sample = kind & 1, win = kind >= 2;
                const int S = sample ? 8192 : 4096, nqb = S >> 8, per = 4 * nqb;
                const int bk = idx / per, rem = idx % per, b = bk >> 1, kvh = bk & 1, hq = kvh * 4 + rem / nqb, qb = rem % nqb;
                const int rowbase = (sample ? MHALF : 0) + b * S;
                if (win) att::attn_win(lds, PROJ, VT, AO, rowbase, S, kvh, rem * 64, lutg, sinkp);
                else att::attn_unit<0>(lds, PROJ, VT, AO, rowbase, S, hq, qb * 256, lutg, bound2);
            }
            }
        }
        PH_END;
        if (PH_ON) {
            const Ids I = ids(bst); CArgs ap = argp(); unsigned char* ws = ap->ws;
            const bf16* wl = (const bf16*)(ws + WS_W) + (size_t)l * W_LAYER;
            pg8::Gemm g{(const bf16*)ap->out, wl + W_O, MTOT, DM, DM}; pg8::StaticOrder S; S.init(MTOT, DM, I.G, I.bx);
            pg8::EpiBf16 E{(bf16*)(ws + WS_PROJ), DM};
#pragma unroll 1
            for (int rep_ = 0; rep_ < DUP_OP; ++rep_)
            pg8::gemm_phase<pg8::EpiBf16, pg8::StaticOrder, true, true>(lds, g, S, E);
        }
        PH_END;
        if (PH_ON) { const Ids I = ids(bst); CArgs ap = argp(); const bf16* mx = (const bf16*)(ap->ws + WS_PROJ);
            ln_phase<false>(ap->out, mx, mx, (bf16*)(ap->ws + WS_XB), ap->in[8] + l * DM, ap->in[9] + l * DM, I.gw, I.ngw, I.lane); }
        PH_END;
#pragma unroll 1
        for (int half = 0; half < 2; ++half) {
            if (PH_ON) {
                const Ids I = ids(bst); CArgs ap = argp(); unsigned char* ws = ap->ws;
                const bf16* wl = (const bf16*)(ws + WS_W) + (size_t)l * W_LAYER;
                pg8::Gemm g{(const bf16*)(ws + WS_XB) + (size_t)half * MHALF * DM, wl + W_GU, MHALF, 2 * DFF, DM}; pg8::StaticOrder S; S.init(MHALF, 2 * DFF, I.G, I.bx);
                pg8::EpiSwiGLU E{(bf16*)(ws + WS_H), DFF};
#pragma unroll 1
                for (int rep_ = 0; rep_ < DUP_FFN1; ++rep_)
                pg8::gemm_phase<pg8::EpiSwiGLU, pg8::StaticOrder, true, true, true>(lds, g, S, E);
            }
            PH_END;
            if (PH_ON) {
                const Ids I = ids(bst); CArgs ap = argp(); unsigned char* ws = ap->ws;
                const bf16* wl = (const bf16*)(ws + WS_W) + (size_t)l * W_LAYER;
                pg8::Gemm g{(const bf16*)(ws + WS_H), wl + W_D, MHALF, DM, DFF}; pg8::StaticOrder S; S.init(MHALF, DM, I.G, I.bx);
                pg8::EpiBf16 E{half == 0 ? (bf16*)(ws + WS_MX0) : (l < DEPTH - 1 ? (bf16*)((char*)ap->out + 128 * MiB) : (bf16*)(ws + WS_W)), DM};
#pragma unroll 1
                for (int rep_ = 0; rep_ < DUP_DN; ++rep_)
                pg8::gemm_phase<pg8::EpiBf16, pg8::StaticOrder, true, true>(lds, g, S, E);
            }
            PH_END;
        }
        if (PH_ON) { const Ids I = ids(bst); CArgs ap = argp(); const bf16* mlo = (const bf16*)(ap->ws + WS_MX0); bf16* xb = (bf16*)(ap->ws + WS_XB);
            const bf16* mhi = (l < DEPTH - 1 ? (const bf16*)((const char*)ap->out + 128 * MiB) : (const bf16*)(ap->ws + WS_W)) - (size_t)MHALF * DM;
            if (l == DEPTH - 1) ln_phase<true>(ap->out, mlo, mhi, xb, ap->in[13] + l * DM, ap->in[14] + l * DM, I.gw, I.ngw, I.lane);
            else ln_phase<false>(ap->out, mlo, mhi, xb, ap->in[13] + l * DM, ap->in[14] + l * DM, I.gw, I.ngw, I.lane); }
        PH_END;
    }
}
constexpr int N_PHASES = 1 + DEPTH * 9;

#ifndef MK_MULTI
#define MK_MULTI 0
#endif
extern "C" void kernel_launch(void* const* d_in, const int* in_sizes, int n_in, void* d_out, int out_size, void* d_ws, size_t ws_size, hipStream_t stream) {
    static int grid = 0;
    if (grid == 0) {
        if (n_in != 15 || out_size != MTOT * DM || ws_size < WS_END) { fprintf(stderr, "kernel_launch: unexpected shapes: n_in %d out %d ws %zu (need %zu)\n", n_in, out_size, ws_size, (size_t)WS_END); grid = -1; return; }
        int dev = 0, cus = 0, per_cu = 0;
        hipGetDevice(&dev); hipDeviceGetAttribute(&cus, hipDeviceAttributeMultiprocessorCount, dev);
        if (hipFuncSetAttribute((const void*)mega_fwd, hipFuncAttributeMaxDynamicSharedMemorySize, LDS_BYTES) != hipSuccess) { fprintf(stderr, "kernel_launch: hipFuncSetAttribute failed\n"); grid = -1; return; }
        if (hipOccupancyMaxActiveBlocksPerMultiprocessor(&per_cu, (const void*)mega_fwd, NWAVES * 64, LDS_BYTES) != hipSuccess || per_cu < 1) { fprintf(stderr, "kernel_launch: occupancy query gave %d\n", per_cu); per_cu = 1; }
        (void)hipGetLastError();
        grid = cus * per_cu;
        fprintf(stderr, "kernel_launch: grid %d (cus %d x %d), ws %zu\n", grid, cus, per_cu, ws_size);
    }
    if (grid < 0) return;
    if (hipMemsetAsync((char*)d_ws + WS_BAR, 0, 16384, stream) != hipSuccess) { fprintf(stderr, "kernel_launch: memset failed\n"); return; }
    Args a{};
    for (int i = 0; i < 15; ++i) a.in[i] = (const float*)d_in[i];
    a.out = (float*)d_out; a.ws = (unsigned char*)d_ws;
#if MK_MULTI
    for (int p = 0; p < N_PHASES; ++p) { a.ph_lo = p; a.ph_hi = p + 1; hipLaunchKernelGGL(mega_fwd, dim3(grid), dim3(NWAVES * 64), LDS_BYTES, stream, a); }
#else
    a.ph_lo = 0; a.ph_hi = N_PHASES;
    void* args[] = {&a};
    hipError_t e = hipLaunchCooperativeKernel((const void*)mega_fwd, dim3(grid), dim3(NWAVES * 64), args, LDS_BYTES, stream);
    if (e != hipSuccess) fprintf(stderr, "cooperative launch failed: %s (grid %d)\n", hipGetErrorString(e), grid);
#endif
}
```

```cpp
#include <hip/hip_runtime.h>
#include <hip/hip_cooperative_groups.h>
#include <cstdio>
#include <cstdint>
namespace cg = cooperative_groups;
#define ALPHA_DN 1.681792830507429f
#define LOG2E_F 1.4426950408889634f
#define QSCALE_F (0.125f * 1.4426950408889634f)
namespace pg8 {
#define PG8_LAS __attribute__((address_space(3)))
typedef unsigned short bf16_t;
typedef short bf16x8 __attribute__((ext_vector_type(8)));
typedef float f32x4 __attribute__((ext_vector_type(4)));
typedef unsigned u32x4 __attribute__((ext_vector_type(4)));
constexpr int BM = 256, BK = 64, HALF = 128, HTB = HALF * BK * 2  , STAGE_BYTES = 8 * HTB, NXCD = 8, WGM = 8;

__host__ __device__ __forceinline__ int lds_byte(int r, int c) { const int st = (r >> 4) * 2 + (c >> 5), rr = r & 15, cc = c & 31, ob = rr * 64 + cc * 2; return st * 1024 + (ob ^ (((ob >> 9) & 1) << 5)); }
__host__ __device__ __forceinline__ void stage_rc(int b, int& R, int& C) { const int st = b / 1024, sb = b % 1024, swz = sb ^ (((sb >> 9) & 1) << 5); R = (st >> 1) * 16 + swz / 64; C = (st & 1) * 32 + (swz % 64) / 2; }
__host__ __device__ __forceinline__ int perm32(int rho) { const int n = rho >> 4, i = rho & 15; return 8 * (i >> 2) + 4 * n + (i & 3); }

struct Unit { int pm, pn; };
struct Gemm { const bf16_t* A; const bf16_t* Bt; int M, N, K; };

struct StaticOrder {
    int nM, nN, nwg, G, c;
    __host__ __device__ void init(int M, int N, int G_, int c_) { nM = M / BM; nN = N / BM; nwg = nM * nN; G = G_; c = c_; }
    __host__ __device__ bool next(int i, Unit& u) const {
        const long L = (long)i * G + c; if (L >= nwg) return false;
        int wgid = (int)L; { const int q = nwg / NXCD, r = nwg % NXCD, xcd = wgid % NXCD, off = wgid / NXCD; wgid = (xcd < r ? xcd * (q + 1) : r * (q + 1) + (xcd - r) * q) + off; }
        const int nig = WGM * nN, gid = wgid / nig, fm = gid * WGM, gsz = (nM - fm) < WGM ? (nM - fm) : WGM;
        u.pm = fm + ((wgid % nig) % gsz); u.pn = (wgid % nig) / gsz; return true;
    }
    __device__ __forceinline__ void a_ready(const Unit&) const {}
    __device__ __forceinline__ void done(const Unit&) const {}
};

__device__ __forceinline__ unsigned cvt_pk_bf16(float lo, float hi) { unsigned r; asm volatile("v_cvt_pk_bf16_f32 %0, %1, %2" : "=v"(r) : "v"(lo), "v"(hi)); return r; }
struct EpiBf16 {
    static constexpr bool PERM = true, AFTER_DRAIN = false;
    bf16_t* O; int ldc;
    __device__ __forceinline__ void operator()(const f32x4 (&acc)[2][2][4][2], const Unit& u, int wr, int wc, int fr, int fq) const {
        const int row0 = u.pm * BM + wr * 64 + fr; const int col0 = u.pn * BM + wc * 32 + 8 * fq;
#pragma unroll
        for (int ai = 0; ai < 2; ++ai)
#pragma unroll
            for (int m = 0; m < 4; ++m) { bf16_t* rowp = O + (size_t)(row0 + ai * HALF + m * 16) * ldc + col0;
#pragma unroll
                for (int bj = 0; bj < 2; ++bj) { const f32x4 v0 = acc[ai][bj][m][0], v1 = acc[ai][bj][m][1];
                    u32x4 w; w.x = cvt_pk_bf16(v0[0], v0[1]); w.y = cvt_pk_bf16(v0[2], v0[3]); w.z = cvt_pk_bf16(v1[0], v1[1]); w.w = cvt_pk_bf16(v1[2], v1[3]);
                    *(u32x4*)(rowp + bj * HALF) = w; } }
    }
};
struct EpiVT {
    static constexpr bool PERM = true, AFTER_DRAIN = false;
    bf16_t* O;
    __device__ __forceinline__ void operator()(const f32x4 (&acc)[2][2][4][2], const Unit& u, int wr, int wc, int fr, int fq) const {
        const int row0 = wr * 64 + fr; const int col0 = u.pn * BM + wc * 32 + 8 * fq;
#pragma unroll
        for (int bj = 0; bj < 2; ++bj) { const int tok = col0 + bj * HALF; bf16_t* tp = O + (size_t)(tok >> 6) * (256 * 64) + (tok & 63);
#pragma unroll
            for (int ai = 0; ai < 2; ++ai)
#pragma unroll
                for (int m = 0; m < 4; ++m) { const f32x4 v0 = acc[ai][bj][m][0], v1 = acc[ai][bj][m][1];
                    u32x4 w; w.x = cvt_pk_bf16(v0[0], v0[1]); w.y = cvt_pk_bf16(v0[2], v0[3]); w.z = cvt_pk_bf16(v1[0], v1[1]); w.w = cvt_pk_bf16(v1[2], v1[3]);
                    *(u32x4*)(tp + (row0 + ai * HALF + m * 16) * 64) = w; } }
    }
};
struct EpiSwiGLU {
    static constexpr bool PERM = true, AFTER_DRAIN = false;
    bf16_t* O; int ldc;
    __device__ __forceinline__ void operator()(const f32x4 (&acc)[2][2][4][2], const Unit& u, int wr, int wc, int fr, int fq) const {
        const int row0 = u.pm * BM + wr * 64 + fr; const int col0 = u.pn * HALF + wc * 32 + 8 * fq;
#pragma unroll
        for (int ai = 0; ai < 2; ++ai)
#pragma unroll
            for (int m = 0; m < 4; ++m) { bf16_t* rowp = O + (size_t)(row0 + ai * HALF + m * 16) * ldc + col0;
                float h[8];
#pragma unroll
                for (int n = 0; n < 2; ++n)
#pragma unroll
                    for (int j = 0; j < 4; ++j) { const float g = acc[ai][0][m][n][j], up = acc[ai][1][m][n][j];
                        const float e = __builtin_amdgcn_exp2f(-g * LOG2E_F); h[n * 4 + j] = g * __builtin_amdgcn_rcpf(1.0f + e) * up; }
                u32x4 w; w.x = cvt_pk_bf16(h[0], h[1]); w.y = cvt_pk_bf16(h[2], h[3]); w.z = cvt_pk_bf16(h[4], h[5]); w.w = cvt_pk_bf16(h[6], h[7]);
                *(u32x4*)rowp = w; }
    }
};
struct EpiProj {
    static constexpr bool PERM = true, AFTER_DRAIN = false;
    bf16_t* O; const float* qg; const float* kg; const PG8_LAS float* rope;
    __device__ __forceinline__ void operator()(const f32x4 (&acc)[2][2][4][2], const Unit& u, int wr, int wc, int fr, int fq) const {
        const int pn = u.pn; int ocol; const float* g = nullptr; float sc = 1.f;
        if (pn < 2) { ocol = (4 * pn + wc) * 64; sc = QSCALE_F; }
        else if (pn < 4) { ocol = 512 + (4 * (pn - 2) + wc) * 64; g = qg; sc = QSCALE_F; }
        else if (wc < 2) { ocol = 1024 + wc * 64; }
        else { ocol = 1152 + (wc - 2) * 64; g = kg; }
        const int row0 = u.pm * BM + wr * 64 + fr;
        if (g == nullptr) {
#pragma unroll
            for (int ai = 0; ai < 2; ++ai)
#pragma unroll
                for (int m = 0; m < 4; ++m) { bf16_t* rowp = O + (size_t)(row0 + ai * HALF + m * 16) * 1280 + ocol + 8 * fq;
#pragma unroll
                    for (int bj = 0; bj < 2; ++bj) { const f32x4 v0 = acc[ai][bj][m][0] * sc, v1 = acc[ai][bj][m][1] * sc;
                        u32x4 w; w.x = cvt_pk_bf16(v0[0], v0[1]); w.y = cvt_pk_bf16(v0[2], v0[3]); w.z = cvt_pk_bf16(v1[0], v1[1]); w.w = cvt_pk_bf16(v1[2], v1[3]);
                        *(u32x4*)(rowp + bj * 32) = w; } }
        } else {
            f32x4 gv[2][2];
#pragma unroll
            for (int bj = 0; bj < 2; ++bj)
#pragma unroll
                for (int n = 0; n < 2; ++n) gv[bj][n] = *(const f32x4*)(g + 32 * bj + 8 * fq + 4 * n) * sc;
#pragma unroll
            for (int ai = 0; ai < 2; ++ai)
#pragma unroll
                for (int m = 0; m < 4; ++m) { const int row = row0 + ai * HALF + m * 16; bf16_t* rowp = O + (size_t)row * 1280 + ocol + 8 * fq;
                    float ss = 0.f;
#pragma unroll
                    for (int bj = 0; bj < 2; ++bj)
#pragma unroll
                        for (int n = 0; n < 2; ++n) { const f32x4 v = acc[ai][bj][m][n]; ss += (v[0] * v[0] + v[1] * v[1]) + (v[2] * v[2] + v[3] * v[3]); }
                    ss += __shfl_xor(ss, 16); ss += __shfl_xor(ss, 32);
                    const float rinv = __builtin_amdgcn_rsqf(ss * (1.0f / 64.0f) + 1e-6f);
                    const int spos = row & (row < 32768 ? 4095 : 8191);
#pragma unroll
                    for (int bj = 0; bj < 2; ++bj) { const int pos = bj == 0 ? (spos >> 6) : (spos & 63); f32x4 o[2];
#pragma unroll
                        for (int n = 0; n < 2; ++n) { const f32x4 cs = *(const PG8_LAS f32x4*)(rope + (pos * 16 + 4 * fq + 2 * n) * 2);
                            const f32x4 y = acc[ai][bj][m][n] * rinv * gv[bj][n];
                            o[n][0] = y[0] * cs[0] - y[1] * cs[1]; o[n][1] = y[0] * cs[1] + y[1] * cs[0];
                            o[n][2] = y[2] * cs[2] - y[3] * cs[3]; o[n][3] = y[2] * cs[3] + y[3] * cs[2]; }
                        u32x4 w; w.x = cvt_pk_bf16(o[0][0], o[0][1]); w.y = cvt_pk_bf16(o[0][2], o[0][3]); w.z = cvt_pk_bf16(o[1][0], o[1][1]); w.w = cvt_pk_bf16(o[1][2], o[1][3]);
                        *(u32x4*)(rowp + bj * 32) = w; } }
        }
    }
};
typedef _Float16 f16x8 __attribute__((ext_vector_type(8)));
template <class Epi, class Sched, bool ALIGN_EPI = false, bool SP2 = false, bool F16 = false>
__device__ __forceinline__ void gemm_phase(PG8_LAS unsigned char* lds, const Gemm g, const Sched& S, const Epi& E) {
    int tid_ = threadIdx.x; asm volatile("" : "+v"(tid_));
    const int tid = tid_, wid = __builtin_amdgcn_readfirstlane(tid >> 6), lane = tid & 63, wr = wid >> 2, wc = wid & 3, fr = lane & 15, fq = lane >> 4;
    const int K = g.K, nt = K / BK;
    unsigned voffA[2], voffB[2];
#pragma unroll
    for (int i = 0; i < 2; ++i) { int R, C; stage_rc(tid * 16 + i * 8192, R, C); const int Rb = Epi::PERM ? ((R & ~31) + perm32(R & 31)) : R;
        voffA[i] = (unsigned)(R * K + C) * 2u; voffB[i] = (unsigned)(Rb * K + C) * 2u; }
    const size_t kstep = (size_t)(BK * 2);
    const size_t hstep = (size_t)HALF * K * 2;
    const size_t tstep = 2 * hstep;
    const unsigned ldsw = (unsigned)wid * 1024u;
    const int aoff = lds_byte(wr * 64 + fr, fq * 8), boff = lds_byte(wc * 32 + fr, fq * 8);
#define PG8_SA(b, h) (((b) * 2 + (h)) * HTB)
#define PG8_SB(b, h) ((4 + (b) * 2 + (h)) * HTB)
#define PG8_STAGE(bufoff, gbase, voff) do { _Pragma("unroll") for (int _i = 0; _i < 2; ++_i) \
        __builtin_amdgcn_global_load_lds((const unsigned*)((const char*)(gbase) + (voff)[_i]), (PG8_LAS unsigned*)(lds + (bufoff) + ldsw + _i * 8192), 16, 0, 0); } while (0)
#define PG8_LDA(dst, b, h) do { _Pragma("unroll") for (int m = 0; m < 4; ++m) _Pragma("unroll") for (int k = 0; k < 2; ++k) dst[m][k] = *(const PG8_LAS bf16x8*)(lds + PG8_SA(b, h) + aoff + m * 2048 + k * 1024); } while (0)
#define PG8_LDB(dst, b, h) do { _Pragma("unroll") for (int n = 0; n < 2; ++n) _Pragma("unroll") for (int k = 0; k < 2; ++k) dst[n][k] = *(const PG8_LAS bf16x8*)(lds + PG8_SB(b, h) + boff + n * 2048 + k * 1024); } while (0)
#define PG8_MMA(ai, bj, At, Bt) do { __builtin_amdgcn_s_setprio(1); _Pragma("unroll") for (int m = 0; m < 4; ++m) _Pragma("unroll") for (int n = 0; n < 2; ++n) _Pragma("unroll") for (int k = 0; k < 2; ++k) \
        acc[ai][bj][m][n] = F16 ? __builtin_amdgcn_mfma_f32_16x16x32_f16(__builtin_bit_cast(f16x8, Bt[n][k]), __builtin_bit_cast(f16x8, At[m][k]), acc[ai][bj][m][n], 0, 0, 0) \
                                : __builtin_amdgcn_mfma_f32_16x16x32_bf16(Bt[n][k], At[m][k], acc[ai][bj][m][n], 0, 0, 0); __builtin_amdgcn_s_setprio(0); } while (0)
#define PG8_WAIT_V(n) asm volatile("s_waitcnt vmcnt(" #n ")" ::: "memory")
#define PG8_WAIT_L(n) asm volatile("s_waitcnt lgkmcnt(" #n ")" ::: "memory")
#define PG8_BAR __builtin_amdgcn_s_barrier()
#define PG8_SCHED __builtin_amdgcn_sched_barrier(0)
    Unit cur, nxt; int ui = 0;
    if (!S.next(0, cur)) return;
    f32x4 acc[2][2][4][2];
#pragma unroll
    for (int a = 0; a < 2; ++a)
#pragma unroll
        for (int b = 0; b < 2; ++b)
#pragma unroll
            for (int m = 0; m < 4; ++m)
#pragma unroll
                for (int n = 0; n < 2; ++n) acc[a][b][m][n] = (f32x4){0.f, 0.f, 0.f, 0.f};
    bf16x8 At[4][2], B0[2][2], B1[2][2];
    const char* cA = (const char*)g.A + (size_t)cur.pm * tstep; const char* cB = (const char*)g.Bt + (size_t)cur.pn * tstep;
    S.a_ready(cur);
    if constexpr (SP2) {
        PG8_STAGE(PG8_SB(0, 0), cB, voffB); PG8_STAGE(PG8_SB(0, 1), cB + hstep, voffB); PG8_STAGE(PG8_SA(0, 0), cA, voffA); PG8_STAGE(PG8_SA(0, 1), cA + hstep, voffA);
        if (wr == 1) PG8_BAR;
        PG8_WAIT_V(2); PG8_BAR;
        PG8_STAGE(PG8_SB(1, 0), cB + kstep, voffB); PG8_STAGE(PG8_SA(1, 0), cA + kstep, voffA); PG8_STAGE(PG8_SB(1, 1), cB + hstep + kstep, voffB);
        PG8_WAIT_V(6); PG8_BAR;
    } else {
        PG8_STAGE(PG8_SB(0, 0), cB, voffB); PG8_STAGE(PG8_SA(0, 0), cA, voffA); PG8_STAGE(PG8_SB(0, 1), cB + hstep, voffB); PG8_STAGE(PG8_SA(0, 1), cA + hstep, voffA);
        if (wr == 1) PG8_BAR;
        PG8_WAIT_V(4); PG8_BAR;
        PG8_STAGE(PG8_SB(1, 0), cB + kstep, voffB); PG8_STAGE(PG8_SA(1, 0), cA + kstep, voffA); PG8_STAGE(PG8_SB(1, 1), cB + hstep + kstep, voffB);
        PG8_WAIT_V(6); PG8_BAR;
    }
    for (;;) {
        const bool has_next = S.next(ui + 1, nxt);
        const char* nA = has_next ? (const char*)g.A + (size_t)nxt.pm * tstep : cA; const char* nB = has_next ? (const char*)g.Bt + (size_t)nxt.pn * tstep : cB;
        for (int t = 0; t < nt; t += 2) {
            const bool last = (t == nt - 2);
            const char* a1 = cA + (size_t)(t + 1) * kstep;
            const char* a2 = last ? nA : cA + (size_t)(t + 2) * kstep; const char* b2 = last ? nB : cB + (size_t)(t + 2) * kstep;
            const char* a3 = a2 + kstep; const char* b3 = b2 + kstep;
            if (last && has_next) S.a_ready(nxt);
            if constexpr (SP2) {
            PG8_LDB(B0, 0, 0); PG8_LDB(B1, 0, 1); PG8_SCHED; PG8_LDA(At, 0, 0); PG8_STAGE(PG8_SA(1, 1), a1 + hstep, voffA);
            PG8_WAIT_V(8); PG8_WAIT_L(0); PG8_BAR; PG8_MMA(0, 0, At, B0); PG8_MMA(0, 1, At, B1); PG8_BAR; PG8_SCHED;
            PG8_LDA(At, 0, 1); PG8_STAGE(PG8_SB(0, 0), b2, voffB); PG8_STAGE(PG8_SB(0, 1), b2 + hstep, voffB); PG8_STAGE(PG8_SA(0, 0), a2, voffA);
            PG8_WAIT_V(8); PG8_WAIT_L(0); PG8_BAR; PG8_MMA(1, 0, At, B0); PG8_MMA(1, 1, At, B1); PG8_BAR; PG8_SCHED;
            PG8_LDB(B0, 1, 0); PG8_LDB(B1, 1, 1); PG8_SCHED; PG8_LDA(At, 1, 0); PG8_STAGE(PG8_SA(0, 1), a2 + hstep, voffA);
            PG8_WAIT_V(8); PG8_WAIT_L(0); PG8_BAR; PG8_MMA(0, 0, At, B0); PG8_MMA(0, 1, At, B1); PG8_BAR; PG8_SCHED;
            PG8_LDA(At, 1, 1); PG8_STAGE(PG8_SB(1, 0), b3, voffB); PG8_STAGE(PG8_SB(1, 1), b3 + hstep, voffB); PG8_STAGE(PG8_SA(1, 0), a3, voffA);
            PG8_WAIT_V(8); PG8_WAIT_L(0); PG8_BAR; PG8_MMA(1, 0, At, B0); PG8_MMA(1, 1, At, B1); PG8_BAR; PG8_SCHED;
            } else {
            PG8_LDB(B0, 0, 0); PG8_SCHED; PG8_LDA(At, 0, 0); PG8_STAGE(PG8_SA(1, 1), a1 + hstep, voffA);
            PG8_WAIT_L(8); PG8_BAR; PG8_WAIT_L(0); PG8_MMA(0, 0, At, B0); PG8_BAR; PG8_SCHED;
            PG8_LDB(B1, 0, 1); PG8_STAGE(PG8_SB(0, 0), b2, voffB);
            PG8_BAR; PG8_WAIT_L(0); PG8_MMA(0, 1, At, B1); PG8_BAR;
            PG8_LDA(At, 0, 1); PG8_STAGE(PG8_SA(0, 0), a2, voffA);
            PG8_BAR; PG8_WAIT_L(0); PG8_MMA(1, 0, At, B0); PG8_BAR; PG8_SCHED;
            PG8_STAGE(PG8_SB(0, 1), b2 + hstep, voffB);
            PG8_WAIT_V(6); PG8_BAR; PG8_MMA(1, 1, At, B1); PG8_BAR;
            PG8_LDB(B0, 1, 0); PG8_SCHED; PG8_LDA(At, 1, 0); PG8_STAGE(PG8_SA(0, 1), a2 + hstep, voffA);
            PG8_WAIT_L(8); PG8_BAR; PG8_WAIT_L(0); PG8_MMA(0, 0, At, B0); PG8_BAR; PG8_SCHED;
            PG8_LDB(B1, 1, 1); PG8_STAGE(PG8_SB(1, 0), b3, voffB);
            PG8_BAR; PG8_WAIT_L(0); PG8_MMA(0, 1, At, B1); PG8_BAR;
            PG8_LDA(At, 1, 1); PG8_STAGE(PG8_SA(1, 0), a3, voffA);
            PG8_BAR; PG8_WAIT_L(0); PG8_MMA(1, 0, At, B0); PG8_BAR; PG8_SCHED;
            PG8_STAGE(PG8_SB(1, 1), b3 + hstep, voffB);
            PG8_WAIT_V(6); PG8_BAR; PG8_MMA(1, 1, At, B1); PG8_BAR;
            }
        }
        if constexpr (ALIGN_EPI) { if (wr == 0) PG8_BAR; }
        if constexpr (!Epi::AFTER_DRAIN) { E(acc, cur, wr, wc, fr, fq); S.done(cur); }
        if (!has_next) break;
#pragma unroll
        for (int a = 0; a < 2; ++a)
#pragma unroll
            for (int b = 0; b < 2; ++b)
#pragma unroll
                for (int m = 0; m < 4; ++m)
#pragma unroll
                    for (int n = 0; n < 2; ++n) acc[a][b][m][n] = (f32x4){0.f, 0.f, 0.f, 0.f};
        cur = nxt; cA = nA; cB = nB; ++ui;
        if constexpr (ALIGN_EPI) { if (wr == 1) PG8_BAR; }
    }
    PG8_WAIT_V(0);
    if constexpr (!ALIGN_EPI) { if (wr == 0) PG8_BAR; }
    PG8_BAR;
    if constexpr (Epi::AFTER_DRAIN) { E.fused(acc, cur, wr, wc, fr, fq, lds, wid, lane); S.done(cur); }
#undef PG8_SA
#undef PG8_SB
#undef PG8_STAGE
#undef PG8_LDA
#undef PG8_LDB
#undef PG8_MMA
#undef PG8_WAIT_V
#undef PG8_WAIT_L
#undef PG8_BAR
#undef PG8_SCHED
}
}
namespace att {
#define LAS __attribute__((address_space(3)))
typedef unsigned short bf16_t;
typedef short bf16x8 __attribute__((ext_vector_type(8)));
typedef float f32x16 __attribute__((ext_vector_type(16)));
typedef float f32x4 __attribute__((ext_vector_type(4)));
typedef unsigned u32x4 __attribute__((ext_vector_type(4)));
typedef unsigned u32x2 __attribute__((ext_vector_type(2)));
typedef float f32x2_t __attribute__((ext_vector_type(2))); typedef __bf16 bf16x2_t __attribute__((ext_vector_type(2)));
__device__ __forceinline__ unsigned cvtpk(float lo, float hi) { f32x2_t v = {lo, hi}; bf16x2_t b = __builtin_convertvector(v, bf16x2_t); return __builtin_bit_cast(unsigned, b); }
constexpr int KP = 144;
constexpr int TB = 64 * KP;
constexpr int OFF_K = 0, OFF_V = 2 * TB, OFF_LUT = 4 * TB, ATT_LDS = 4 * TB + 4 * 452 * 4;
constexpr int PITCH_P = 1280, PITCH_VT = 65536, PITCH_O = 1024;

template <int WIN>
__device__ __forceinline__ void attn_unit(LAS unsigned char* lds, const bf16_t* __restrict__ PROJ, const bf16_t* __restrict__ VT, bf16_t* __restrict__ AO,
                                          int rowbase, int S, int hq, int q0, const float* __restrict__ lut_g, float sink2  ) {
    int tid_ = threadIdx.x; asm volatile("" : "+v"(tid_));
    const int tid = tid_, lane = tid & 63, r32 = lane & 31, hi = lane >> 5; const int wid = __builtin_amdgcn_readfirstlane(tid >> 6);
    const int kvh = hq >> 2;
    const int qcol = WIN ? hq * 64 : 512 + hq * 64;
    const int kcol = WIN ? 1024 + kvh * 64 : 1152 + kvh * 64;
    const int vrow0 = WIN ? kvh * 64 : 128 + kvh * 64;
    const int ocol = WIN ? hq * 64 : 512 + hq * 64;
    int kt0 = 0, kt1 = S >> 6;
    if (WIN) { const int lo = q0 - 128, hi_ = q0 + 256 + 128; kt0 = (lo < 0 ? 0 : lo) >> 6; kt1 = (hi_ > S ? S : hi_) >> 6; }
    const int krow = tid >> 3, kch = tid & 7;
    const bf16_t* ksrc = PROJ + (size_t)(rowbase + krow) * PITCH_P + kcol + kch * 8;
    const bf16_t* vsrc = VT + ((size_t)(rowbase >> 6) * 256 + vrow0 + krow) * 64 + kch * 8;
    const int kdst = OFF_K + krow * KP + kch * 16;
    const int vdst = OFF_V + krow * KP + (kch >> 1) * 32 + (kch & 1) * 8;
    LAS float* lut = (LAS float*)(lds + OFF_LUT);
    if (WIN) { if (tid < 257) lut[tid] = lut_g[tid]; }
    const int qw = q0 + wid * 32;
    const bf16_t* qp = PROJ + (size_t)(rowbase + qw + r32) * PITCH_P + qcol + hi * 8;
    bf16x8 qf[4];
#pragma unroll
    for (int ds = 0; ds < 4; ++ds) qf[ds] = *(const bf16x8*)(qp + ds * 16);
    u32x4 kreg = *(const u32x4*)(ksrc + (size_t)kt0 * 64 * PITCH_P);
    u32x4 vreg = *(const u32x4*)(vsrc + (size_t)kt0 * 16384);
    *(LAS u32x4*)(lds + kdst) = kreg;
    *(LAS u32x2*)(lds + vdst) = (u32x2){vreg.x, vreg.y}; *(LAS u32x2*)(lds + vdst + 16) = (u32x2){vreg.z, vreg.w};
    if (kt0 + 1 < kt1) { kreg = *(const u32x4*)(ksrc + (size_t)(kt0 + 1) * 64 * PITCH_P); vreg = *(const u32x4*)(vsrc + (size_t)(kt0 + 1) * 16384); }
    float m = WIN ? sink2 : 0.f, l = WIN ? 0.5f : 0.f;
    f32x16 negb; { const float nb_ = WIN ? 0.f : -sink2;
#pragma unroll
      for (int r = 0; r < 16; ++r) negb[r] = nb_; }
    f32x16 o0 = {}, o1 = {};
    __syncthreads();
    for (int t = kt0; t < kt1; ++t) {
        const int cur = (t - kt0) & 1;
        if (t + 1 < kt1) {
            const int nb = (cur ^ 1) * TB;
            *(LAS u32x4*)(lds + nb + kdst) = kreg;
            *(LAS u32x2*)(lds + nb + vdst) = (u32x2){vreg.x, vreg.y}; *(LAS u32x2*)(lds + nb + vdst + 16) = (u32x2){vreg.z, vreg.w};
            if (t + 2 < kt1) { kreg = *(const u32x4*)(ksrc + (size_t)(t + 2) * 64 * PITCH_P); vreg = *(const u32x4*)(vsrc + (size_t)(t + 2) * 16384); }
        }
        const int k0 = t * 64;
        bool active = true;
        if (WIN) active = (k0 + 63 >= qw - 128) && (k0 <= qw + 31 + 128);
        if (active) {
            const LAS unsigned char* kb = lds + OFF_K + cur * TB + r32 * KP + hi * 16;
            f32x16 sA = negb, sB = negb;
#pragma unroll
            for (int ds = 0; ds < 4; ++ds) {
                const bf16x8 ka = *(const LAS bf16x8*)(kb + ds * 32);
                const bf16x8 kb2 = *(const LAS bf16x8*)(kb + 32 * KP + ds * 32);
                sA = __builtin_amdgcn_mfma_f32_32x32x16_bf16(ka, qf[ds], sA, 0, 0, 0);
                sB = __builtin_amdgcn_mfma_f32_32x32x16_bf16(kb2, qf[ds], sB, 0, 0, 0);
            }
            if (WIN) {
                const int qpos = qw + r32;
#pragma unroll
                for (int r = 0; r < 16; ++r) {
                    const int key = k0 + (r & 3) + 8 * (r >> 2) + 4 * hi;
                    int relA = key - qpos + 128, relB = relA + 32;
                    const bool vA = (relA >= 0) && (relA <= 256), vB = (relB >= 0) && (relB <= 256);
                    relA = relA < 0 ? 0 : (relA > 256 ? 256 : relA); relB = relB < 0 ? 0 : (relB > 256 ? 256 : relB);
                    sA[r] = vA ? sA[r] + lut[relA] : -1e30f; sB[r] = vB ? sB[r] + lut[relB] : -1e30f;
                }
            }
            if (WIN) {
            float mx = fmaxf(sA[0], sB[0]);
#pragma unroll
            for (int r = 1; r < 16; ++r) mx = fmaxf(mx, fmaxf(sA[r], sB[r]));
            mx = fmaxf(mx, __shfl_xor(mx, 32));
            const float mn = fmaxf(m, mx);
            const float alpha = __builtin_amdgcn_exp2f(m - mn);
            m = mn;
            float ps = 0.f;
#pragma unroll
            for (int r = 0; r < 16; ++r) { sA[r] = __builtin_amdgcn_exp2f(sA[r] - mn); sB[r] = __builtin_amdgcn_exp2f(sB[r] - mn); ps += sA[r] + sB[r]; }
            l = l * alpha + ps;
#pragma unroll
            for (int r = 0; r < 16; ++r) { o0[r] *= alpha; o1[r] *= alpha; }
            } else {
                float ps = 0.f;
#pragma unroll
                for (int r = 0; r < 16; ++r) { sA[r] = __builtin_amdgcn_exp2f(sA[r]); sB[r] = __builtin_amdgcn_exp2f(sB[r]); ps += sA[r] + sB[r]; }
                l += ps;
            }
            bf16x8 pk[4];
            { u32x4 w;
              w.x = cvtpk(sA[0], sA[1]); w.y = cvtpk(sA[2], sA[3]); w.z = cvtpk(sA[4], sA[5]); w.w = cvtpk(sA[6], sA[7]); pk[0] = __builtin_bit_cast(bf16x8, w);
              w.x = cvtpk(sA[8], sA[9]); w.y = cvtpk(sA[10], sA[11]); w.z = cvtpk(sA[12], sA[13]); w.w = cvtpk(sA[14], sA[15]); pk[1] = __builtin_bit_cast(bf16x8, w);
              w.x = cvtpk(sB[0], sB[1]); w.y = cvtpk(sB[2], sB[3]); w.z = cvtpk(sB[4], sB[5]); w.w = cvtpk(sB[6], sB[7]); pk[2] = __builtin_bit_cast(bf16x8, w);
              w.x = cvtpk(sB[8], sB[9]); w.y = cvtpk(sB[10], sB[11]); w.z = cvtpk(sB[12], sB[13]); w.w = cvtpk(sB[14], sB[15]); pk[3] = __builtin_bit_cast(bf16x8, w); }
            const LAS unsigned char* vb = lds + OFF_V + cur * TB + r32 * KP + hi * 16;
#pragma unroll
            for (int s = 0; s < 4; ++s) {
                const bf16x8 va = *(const LAS bf16x8*)(vb + s * 32);
                const bf16x8 vb2 = *(const LAS bf16x8*)(vb + 32 * KP + s * 32);
                o0 = __builtin_amdgcn_mfma_f32_32x32x16_bf16(va, pk[s], o0, 0, 0, 0);
                o1 = __builtin_amdgcn_mfma_f32_32x32x16_bf16(vb2, pk[s], o1, 0, 0, 0);
            }
        }
        asm volatile("s_waitcnt lgkmcnt(0)\n\ts_barrier" ::: "memory");
    }
    const float lt = l + __shfl_xor(l, 32);
    const float inv = 1.0f / lt;
    bf16_t* op = AO + (size_t)(rowbase + qw + r32) * PITCH_O + ocol + 4 * hi;
#pragma unroll
    for (int g4 = 0; g4 < 4; ++g4) {
        u32x2 w0, w1;
        w0.x = cvtpk(o0[4 * g4] * inv, o0[4 * g4 + 1] * inv); w0.y = cvtpk(o0[4 * g4 + 2] * inv, o0[4 * g4 + 3] * inv);
        w1.x = cvtpk(o1[4 * g4] * inv, o1[4 * g4 + 1] * inv); w1.y = cvtpk(o1[4 * g4 + 2] * inv, o1[4 * g4 + 3] * inv);
        *(u32x2*)(op + 8 * g4) = w0; *(u32x2*)(op + 32 + 8 * g4) = w1;
    }
}

#define ATT_BAR() asm volatile("s_waitcnt lgkmcnt(0)\n\ts_barrier" ::: "memory")
__device__ __forceinline__ void attn_global(LAS unsigned char* lds, const bf16_t* __restrict__ PROJ, const bf16_t* __restrict__ VT, bf16_t* __restrict__ AO,
                                            int rowbase, int S, int hq, int q0, float bound2) {
    int tid_ = threadIdx.x; asm volatile("" : "+v"(tid_));
    const int tid = tid_, lane = tid & 63, r32 = lane & 31, hi = lane >> 5; const int wid = __builtin_amdgcn_readfirstlane(tid >> 6);
    const int kvh = hq >> 2, qcol = 512 + hq * 64, kcol = 1152 + kvh * 64, vrow0 = 128 + kvh * 64, ocol = 512 + hq * 64;
    const int T = S >> 6;
    const int krow = tid >> 3, kch = tid & 7;
    const bf16_t* ksrc = PROJ + (size_t)(rowbase + krow) * PITCH_P + kcol + kch * 8;
    const bf16_t* vsrc = VT + ((size_t)(rowbase >> 6) * 256 + vrow0 + krow) * 64 + kch * 8;
    constexpr int RK = 0, RV = 4 * TB;
    const int kdst = RK + krow * KP + kch * 16;
    const int vdst = RV + krow * KP + (kch >> 1) * 32 + (kch & 1) * 8;
    const int qw = q0 + wid * 32;
    const bf16_t* qp = PROJ + (size_t)(rowbase + qw + r32) * PITCH_P + qcol + hi * 8;
    bf16x8 qf[4];
#pragma unroll
    for (int ds = 0; ds < 4; ++ds) qf[ds] = *(const bf16x8*)(qp + ds * 16);
#define LDK(t) (*(const u32x4*)(ksrc + (size_t)(t) * 64 * PITCH_P))
#define LDV(t) (*(const u32x4*)(vsrc + (size_t)(t) * 16384))
#define STK(slot, reg) (*(LAS u32x4*)(lds + (slot) * TB + kdst) = (reg))
#define STV(slot, reg) do { *(LAS u32x2*)(lds + (slot) * TB + vdst) = (u32x2){(reg).x, (reg).y}; *(LAS u32x2*)(lds + (slot) * TB + vdst + 16) = (u32x2){(reg).z, (reg).w}; } while (0)
    u32x4 kra, krb, vra, vrb;
    kra = LDK(0); krb = LDK(1); vra = LDV(0); vrb = LDV(1);
    STK(0, kra); STK(1, krb); STV(0, vra); STV(1, vrb);
    kra = LDK(2); STK(2, kra);
    kra = LDK(3); krb = LDK(4); vra = LDV(2); vrb = LDV(3);
    const f32x16 zero16 = {};
    const bf16x2_t ones2 = __builtin_bit_cast(bf16x2_t, 0x3F803F80u);
    float lsum = 0.f;
    f32x16 o0 = {}, o1 = {}, sA, sB, nA, nB;
    const LAS unsigned char* kfb = lds + RK + r32 * KP + hi * 16;
    const LAS unsigned char* vfb = lds + RV + r32 * KP + hi * 16;
#define QK_TILE(SA, SB, slot) do { _Pragma("unroll") for (int ds = 0; ds < 4; ++ds) { \
        const bf16x8 ka_ = *(const LAS bf16x8*)(kfb + (slot) * TB + ds * 32), kb_ = *(const LAS bf16x8*)(kfb + (slot) * TB + 32 * KP + ds * 32); \
        SA = __builtin_amdgcn_mfma_f32_32x32x16_bf16(ka_, qf[ds], ds == 0 ? zero16 : SA, 0, 0, 0); \
        SB = __builtin_amdgcn_mfma_f32_32x32x16_bf16(kb_, qf[ds], ds == 0 ? zero16 : SB, 0, 0, 0); } } while (0)
    ATT_BAR();
    QK_TILE(sA, sB, 0);
    ATT_BAR();
#define ATT_HALF(SA, SB, NA, NB, ks, vs, DOQK) do { \
        if (DOQK) QK_TILE(NA, NB, ks); \
        _Pragma("unroll") for (int r = 0; r < 16; ++r) { SA[r] = __builtin_amdgcn_exp2f(SA[r]); SB[r] = __builtin_amdgcn_exp2f(SB[r]); } \
        bf16x8 pk_[4]; { u32x4 w_; \
          w_.x = cvtpk(SA[0], SA[1]); w_.y = cvtpk(SA[2], SA[3]); w_.z = cvtpk(SA[4], SA[5]); w_.w = cvtpk(SA[6], SA[7]); pk_[0] = __builtin_bit_cast(bf16x8, w_); \
          w_.x = cvtpk(SA[8], SA[9]); w_.y = cvtpk(SA[10], SA[11]); w_.z = cvtpk(SA[12], SA[13]); w_.w = cvtpk(SA[14], SA[15]); pk_[1] = __builtin_bit_cast(bf16x8, w_); \
          w_.x = cvtpk(SB[0], SB[1]); w_.y = cvtpk(SB[2], SB[3]); w_.z = cvtpk(SB[4], SB[5]); w_.w = cvtpk(SB[6], SB[7]); pk_[2] = __builtin_bit_cast(bf16x8, w_); \
          w_.x = cvtpk(SB[8], SB[9]); w_.y = cvtpk(SB[10], SB[11]); w_.z = cvtpk(SB[12], SB[13]); w_.w = cvtpk(SB[14], SB[15]); pk_[3] = __builtin_bit_cast(bf16x8, w_); } \
        _Pragma("unroll") for (int s = 0; s < 4; ++s) { const u32x4 pw_ = __builtin_bit_cast(u32x4, pk_[s]); \
            _Pragma("unroll") for (int k = 0; k < 4; ++k) lsum = __builtin_amdgcn_fdot2_f32_bf16(__builtin_bit_cast(bf16x2_t, pw_[k]), ones2, lsum, false); } \
        _Pragma("unroll") for (int s = 0; s < 4; ++s) { \
            const bf16x8 va_ = *(const LAS bf16x8*)(vfb + (vs) * TB + s * 32), vb_ = *(const LAS bf16x8*)(vfb + (vs) * TB + 32 * KP + s * 32); \
            o0 = __builtin_amdgcn_mfma_f32_32x32x16_bf16(va_, pk_[s], o0, 0, 0, 0); \
            o1 = __builtin_amdgcn_mfma_f32_32x32x16_bf16(vb_, pk_[s], o1, 0, 0, 0); \
            } } while (0)
#define ATT_DSTEP(t, p, FULL) do { \
        if (FULL || (t) + 3 < T) STK(((p) + 3) & 3, kra); \
        if (FULL || (t) + 4 < T) STK((p), krb); \
        if (FULL || (t) + 2 < T) STV(((p) + 2) & 3, vra); \
        if (FULL || (t) + 3 < T) STV(((p) + 3) & 3, vrb); \
        if (FULL || (t) + 5 < T) kra = LDK((t) + 5); \
        if (FULL || (t) + 6 < T) krb = LDK((t) + 6); \
        if (FULL || (t) + 4 < T) vra = LDV((t) + 4); \
        if (FULL || (t) + 5 < T) vrb = LDV((t) + 5); \
        ATT_HALF(sA, sB, nA, nB, ((p) + 1) & 3, (p), (FULL || (t) + 1 < T)); \
        ATT_HALF(nA, nB, sA, sB, ((p) + 2) & 3, ((p) + 1) & 3, (FULL || (t) + 2 < T)); \
        ATT_BAR(); } while (0)
    int t = 0;
#pragma unroll 1
    for (; t + 10 < T; t += 4) { ATT_DSTEP(t, 0, true); ATT_DSTEP(t + 2, 2, true); }
#pragma unroll 1
    for (; t < T; t += 4) { ATT_DSTEP(t, 0, false); ATT_DSTEP(t + 2, 2, false); }
#undef ATT_DSTEP
#undef ATT_HALF
#undef QK_TILE
#undef LDK
#undef LDV
#undef STK
#undef STV
    const float inv = 1.0f / (lsum + __shfl_xor(lsum, 32));
    bf16_t* op = AO + (size_t)(rowbase + qw + r32) * PITCH_O + ocol + 4 * hi;
#pragma unroll
    for (int g4 = 0; g4 < 4; ++g4) {
        u32x2 w0, w1;
        w0.x = cvtpk(o0[4 * g4] * inv, o0[4 * g4 + 1] * inv); w0.y = cvtpk(o0[4 * g4 + 2] * inv, o0[4 * g4 + 3] * inv);
        w1.x = cvtpk(o1[4 * g4] * inv, o1[4 * g4 + 1] * inv); w1.y = cvtpk(o1[4 * g4 + 2] * inv, o1[4 * g4 + 3] * inv);
        *(u32x2*)(op + 8 * g4) = w0; *(u32x2*)(op + 32 + 8 * g4) = w1;
    }
}

__device__ __forceinline__ void attn_win(LAS unsigned char* lds, const bf16_t* __restrict__ PROJ, const bf16_t* __restrict__ VT, bf16_t* __restrict__ AO,
                                         int rowbase, int S, int kvh, int q0, const float* __restrict__ lut_g  , const float* __restrict__ sinkp  ) {
    int tid_ = threadIdx.x; asm volatile("" : "+v"(tid_));
    const int tid = tid_, lane = tid & 63, r32 = lane & 31, hi = lane >> 5; const int wid = __builtin_amdgcn_readfirstlane(tid >> 6);
    const int hq = kvh * 4 + (wid >> 1);
    const int qcol = hq * 64, kcol = 1024 + kvh * 64, vrow0 = kvh * 64, ocol = hq * 64;
    const int lo = q0 - 128, hi_ = q0 + 64 + 128;
    const int kt0 = (lo < 0 ? 0 : lo) >> 6, kt1 = (hi_ > S ? S : hi_) >> 6;
    const int krow = tid >> 3, kch = tid & 7;
    const bf16_t* ksrc = PROJ + (size_t)(rowbase + krow) * PITCH_P + kcol + kch * 8;
    const bf16_t* vsrc = VT + ((size_t)(rowbase >> 6) * 256 + vrow0 + krow) * 64 + kch * 8;
    const int kdst = OFF_K + krow * KP + kch * 16;
    const int vdst = OFF_V + krow * KP + (kch >> 1) * 32 + (kch & 1) * 8;
    LAS float* lut4 = (LAS float*)(lds + OFF_LUT);
    for (int i = tid; i < 4 * 452; i += 512) lut4[i] = lut_g[kvh * 4 * 452 + i];
    const LAS float* lut = lut4 + (wid >> 1) * 452;
    const float sink2 = sinkp[hq] * LOG2E_F;
    const int qw = q0 + (wid & 1) * 32;
    const bf16_t* qp = PROJ + (size_t)(rowbase + qw + r32) * PITCH_P + qcol + hi * 8;
    bf16x8 qf[4];
#pragma unroll
    for (int ds = 0; ds < 4; ++ds) qf[ds] = *(const bf16x8*)(qp + ds * 16);
    u32x4 kreg = *(const u32x4*)(ksrc + (size_t)kt0 * 64 * PITCH_P);
    u32x4 vreg = *(const u32x4*)(vsrc + (size_t)kt0 * 16384);
    *(LAS u32x4*)(lds + kdst) = kreg;
    *(LAS u32x2*)(lds + vdst) = (u32x2){vreg.x, vreg.y}; *(LAS u32x2*)(lds + vdst + 16) = (u32x2){vreg.z, vreg.w};
    if (kt0 + 1 < kt1) { kreg = *(const u32x4*)(ksrc + (size_t)(kt0 + 1) * 64 * PITCH_P); vreg = *(const u32x4*)(vsrc + (size_t)(kt0 + 1) * 16384); }
    float m = sink2, l = 0.5f;
    f32x16 o0 = {}, o1 = {};
    asm volatile("s_waitcnt lgkmcnt(0)\n\ts_barrier" ::: "memory");
    for (int t = kt0; t < kt1; ++t) {
        const int cur = (t - kt0) & 1;
        if (t + 1 < kt1) {
            const int nb = (cur ^ 1) * TB;
            *(LAS u32x4*)(lds + nb + kdst) = kreg;
            *(LAS u32x2*)(lds + nb + vdst) = (u32x2){vreg.x, vreg.y}; *(LAS u32x2*)(lds + nb + vdst + 16) = (u32x2){vreg.z, vreg.w};
            if (t + 2 < kt1) { kreg = *(const u32x4*)(ksrc + (size_t)(t + 2) * 64 * PITCH_P); vreg = *(const u32x4*)(vsrc + (size_t)(t + 2) * 16384); }
        }
        const int k0 = t * 64;
        if ((k0 + 63 >= qw - 128) && (k0 <= qw + 31 + 128)) {
            const LAS unsigned char* kb = lds + OFF_K + cur * TB + r32 * KP + hi * 16;
            f32x16 sA = {}, sB = {};
#pragma unroll
            for (int ds = 0; ds < 4; ++ds) {
                const bf16x8 ka = *(const LAS bf16x8*)(kb + ds * 32);
                const bf16x8 kb2 = *(const LAS bf16x8*)(kb + 32 * KP + ds * 32);
                sA = __builtin_amdgcn_mfma_f32_32x32x16_bf16(ka, qf[ds], sA, 0, 0, 0);
                sB = __builtin_amdgcn_mfma_f32_32x32x16_bf16(kb2, qf[ds], sB, 0, 0, 0);
            }
            { const LAS float* lp = lut + (k0 - (qw + r32) + 224 + 4 * hi);
#pragma unroll
              for (int r = 0; r < 16; ++r) { sA[r] += lp[(r & 3) + 8 * (r >> 2)]; sB[r] += lp[32 + (r & 3) + 8 * (r >> 2)]; } }
            float mx = fmaxf(sA[0], sB[0]);
#pragma unroll
            for (int r = 1; r < 16; ++r) mx = fmaxf(mx, fmaxf(sA[r], sB[r]));
            mx = fmaxf(mx, __shfl_xor(mx, 32));
            const float mn = fmaxf(m, mx);
            const float alpha = __builtin_amdgcn_exp2f(m - mn);
            m = mn;
            float ps = 0.f;
#pragma unroll
            for (int r = 0; r < 16; ++r) { sA[r] = __builtin_amdgcn_exp2f(sA[r] - mn); sB[r] = __builtin_amdgcn_exp2f(sB[r] - mn); ps += sA[r] + sB[r]; }
            l = l * alpha + ps;
#pragma unroll
            for (int r = 0; r < 16; ++r) { o0[r] *= alpha; o1[r] *= alpha; }
            bf16x8 pk[4];
            { u32x4 w;
              w.x = cvtpk(sA[0], sA[1]); w.y = cvtpk(sA[2], sA[3]); w.z = cvtpk(sA[4], sA[5]); w.w = cvtpk(sA[6], sA[7]); pk[0] = __builtin_bit_cast(bf16x8, w);
              w.x = cvtpk(sA[8], sA[9]); w.y = cvtpk(sA[10], sA[11]); w.z = cvtpk(sA[12], sA[13]); w.w = cvtpk(sA[14], sA[15]); pk[1] = __builtin_bit_cast(bf16x8, w);
              w.x = cvtpk(sB[0], sB[1]); w.y = cvtpk(sB[2], sB[3]); w.z = cvtpk(sB[4], sB[5]); w.w = cvtpk(sB[6], sB[7]); pk[2] = __builtin_bit_cast(bf16x8, w);
              w.x = cvtpk(sB[8], sB[9]); w.y = cvtpk(sB[10], sB[11]); w.z = cvtpk(sB[12], sB[13]); w.w = cvtpk(sB[14], sB[15]); pk[3] = __builtin_bit_cast(bf16x8, w); }
            const LAS unsigned char* vb = lds + OFF_V + cur * TB + r32 * KP + hi * 16;
#pragma unroll
            for (int s = 0; s < 4; ++s) {
                const bf16x8 va = *(const LAS bf16x8*)(vb + s * 32);
                const bf16x8 vb2 = *(const LAS bf16x8*)(vb + 32 * KP + s * 32);
                o0 = __builtin_amdgcn_mfma_f32_32x32x16_bf16(va, pk[s], o0, 0, 0, 0);
                o1 = __builtin_amdgcn_mfma_f32_32x32x16_bf16(vb2, pk[s], o1, 0, 0, 0);
            }
        }
        asm volatile("s_waitcnt lgkmcnt(0)\n\ts_barrier" ::: "memory");
    }
    const float lt = l + __shfl_xor(l, 32);
    const float inv = 1.0f / lt;
    bf16_t* op = AO + (size_t)(rowbase + qw + r32) * PITCH_O + ocol + 4 * hi;
#pragma unroll
    for (int g4 = 0; g4 < 4; ++g4) {
        u32x2 w0, w1;
        w0.x = cvtpk(o0[4 * g4] * inv, o0[4 * g4 + 1] * inv); w0.y = cvtpk(o0[4 * g4 + 2] * inv, o0[4 * g4 + 3] * inv);
        w1.x = cvtpk(o1[4 * g4] * inv, o1[4 * g4 + 1] * inv); w1.y = cvtpk(o1[4 * g4 + 2] * inv, o1[4 * g4 + 3] * inv);
        *(u32x2*)(op + 8 * g4) = w0; *(u32x2*)(op + 32 + 8 * g4) = w1;
    }
}
}

typedef unsigned short bf16;
typedef unsigned v4u __attribute__((ext_vector_type(4)));
typedef unsigned v2u __attribute__((ext_vector_type(2)));
typedef float f32x4 __attribute__((ext_vector_type(4)));
constexpr int NWAVES = 8;
#ifndef DUP_ATT
#define DUP_ATT 1
#endif
#ifndef DUP_FFN1
#define DUP_FFN1 1
#endif
#ifndef DUP_LN
#define DUP_LN 1
#endif
#ifndef DUP_PRO
#define DUP_PRO 1
#endif
#ifndef DUP_P1
#define DUP_P1 1
#endif
#ifndef DUP_OP
#define DUP_OP 1
#endif
#ifndef DUP_DN
#define DUP_DN 1
#endif
constexpr int DM = 1024, DIN = 1536, DFF = 2816, DEPTH = 4, MTOT = 65536, MHALF = 32768, NPROJ = 1280;
constexpr size_t MiB = 1u << 20;
constexpr size_t WS_ROPE = 0;
constexpr size_t WS_LUT = 32768;
constexpr size_t WS_STATS = 256 * 1024;
constexpr size_t WS_W = 1 * MiB;
constexpr size_t W_P = 0, W_V = W_P + (size_t)1280 * 1024, W_O = W_V + (size_t)256 * 1024, W_GU = W_O + (size_t)1024 * 1024, W_D = W_GU + (size_t)5632 * 1024, W_LAYER = W_D + (size_t)1024 * 2816;
constexpr size_t WS_XB = 88 * MiB;
constexpr size_t WS_PROJ = 216 * MiB;
constexpr size_t WS_VT = 376 * MiB;
constexpr size_t WS_H = 216 * MiB;
constexpr size_t WS_MX0 = 408 * MiB;
constexpr size_t WS_END = 472 * MiB;
static_assert(W_LAYER * 2 * 3 >= (size_t)MHALF * DM * 2 && WS_W + W_LAYER * 2 * DEPTH <= WS_XB && WS_H + (size_t)MHALF * DFF * 2 <= WS_END, "ws map");
constexpr int LDS_ROPE = 131328;
constexpr int LDS_BYTES = 147968;

constexpr size_t WS_BAR = 65536;
#define XB_TMO      128
#define XB_XCNT(j)  (256  + 64 * (j))
#define XB_XSUB(j)  (1280 + 64 * (j))
#define XB_XGEN(j)  (2304 + 64 * (j))
#define XB_TOP      3328
#define XB_TOPGEN   3392
#define XCD_BAR_WORDS 3456
#define XB_SPIN_CAP (1u << 18)

__device__ __forceinline__ unsigned xb_ld(unsigned* p)              { return __hip_atomic_load(p, __ATOMIC_RELAXED, __HIP_MEMORY_SCOPE_AGENT); }
__device__ __forceinline__ unsigned xb_add(unsigned* p, unsigned v) { return __hip_atomic_fetch_add(p, v, __ATOMIC_RELAXED, __HIP_MEMORY_SCOPE_AGENT); }
__device__ __forceinline__ unsigned xb_xcc_id() { return (unsigned)__builtin_amdgcn_s_getreg((3 << 11) | 20) & 0xFu; }
#define XB_SPIN(cond, bar) do { unsigned _sp = 0; while (cond) { __builtin_amdgcn_s_sleep(1); \
    if ((++_sp & 255u) == 0u) { if (xb_ld(&(bar)[XB_TMO])) break; if (_sp > XB_SPIN_CAP) { atomicAdd(&(bar)[XB_TMO], 1u); break; } } } } while (0)

struct XcdBarrier {
    unsigned* bar; unsigned x;
    volatile LAS unsigned* st;
};

__device__ __forceinline__ XcdBarrier xcd_barrier_post(unsigned* bar, volatile LAS unsigned* st) {
    XcdBarrier b; b.bar = bar; b.x = xb_xcc_id(); b.st = st;
    if (threadIdx.x == 0) (void)xb_add(&bar[XB_XCNT(b.x)], 1u);
    return b;
}
__device__ __forceinline__ void xcd_barrier_complete(unsigned* bar, unsigned x, unsigned& nloc, unsigned& nx) {
    const unsigned G = gridDim.x * gridDim.y * gridDim.z;
    unsigned sum, cnt, mine, sp = 0u;
    for (;;) {
        sum = 0u; cnt = 0u; mine = 0u;
#pragma unroll
        for (unsigned j = 0; j < 16; ++j) { const unsigned c = xb_ld(&bar[XB_XCNT(j)]); sum += c; cnt += (c > 0u) ? 1u : 0u; mine = (j == x) ? c : mine; }
        if (sum == G) break;
        __builtin_amdgcn_s_sleep(1);
        if ((++sp & 255u) == 0u) { if (xb_ld(&bar[XB_TMO])) break; if (sp > XB_SPIN_CAP) { atomicAdd(&bar[XB_TMO], 1u); break; } }
    }
    nloc = mine > 0u ? mine : 1u; nx = cnt > 0u ? cnt : 1u;
}

__device__ __forceinline__ void xcd_barrier(const XcdBarrier& b) {
    asm volatile("s_waitcnt vmcnt(0)" ::: "memory");
    __syncthreads();
    if (threadIdx.x == 0) {
        unsigned* bar = b.bar;
        __builtin_amdgcn_s_waitcnt(0);
        unsigned nloc = b.st[0], nx = b.st[1];
        if (nloc == 0u) { xcd_barrier_complete(bar, b.x, nloc, nx); b.st[0] = nloc; b.st[1] = nx; }
        const unsigned old = xb_add(&bar[XB_XSUB(b.x)], 1u);
        const unsigned gen = old / nloc;
        if (old + 1u == (gen + 1u) * nloc) {
            __builtin_amdgcn_fence(__ATOMIC_RELEASE, "agent");
            asm volatile("s_waitcnt vmcnt(0)" ::: "memory");
            const unsigned og = xb_add(&bar[XB_TOP], 1u);
            const unsigned tg = og / nx;
            if (og + 1u == (tg + 1u) * nx) xb_add(&bar[XB_TOPGEN], 1u);
            else XB_SPIN(xb_ld(&bar[XB_TOPGEN]) == tg, bar);
            __builtin_amdgcn_fence(__ATOMIC_ACQUIRE, "agent");
            xb_add(&bar[XB_XGEN(b.x)], 1u);
            asm volatile("s_waitcnt vmcnt(0)" ::: "memory");
        } else {
            XB_SPIN(xb_ld(&bar[XB_XGEN(b.x)]) == gen, bar);
            __builtin_amdgcn_fence(__ATOMIC_ACQUIRE, "agent");
            asm volatile("s_waitcnt vmcnt(0)" ::: "memory");
        }
    }
    __syncthreads();
}

struct Args { const float* in[15]; float* out; unsigned char* ws; int ph_lo, ph_hi; };

__device__ __forceinline__ unsigned f2bf(float f) { unsigned u = __builtin_bit_cast(unsigned, f); return (u + 0x7fffu + ((u >> 16) & 1u)) >> 16; }
__device__ __forceinline__ unsigned pk2(float lo, float hi) { return f2bf(lo) | (f2bf(hi) << 16); }
typedef _Float16 h16x2 __attribute__((ext_vector_type(2))); typedef _Float16 h16x4 __attribute__((ext_vector_type(4))); typedef float f32x2p __attribute__((ext_vector_type(2)));
__device__ __forceinline__ unsigned pkh(float lo, float hi) { f32x2p v = {lo, hi}; return __builtin_bit_cast(unsigned, __builtin_convertvector(v, h16x2)); }
template <bool H> __device__ __forceinline__ unsigned pk16(float lo, float hi) { return H ? pkh(lo, hi) : pk2(lo, hi); }
__device__ __forceinline__ float wave_sum(float v) {
#pragma unroll
    for (int o = 1; o < 64; o <<= 1) v += __shfl_xor(v, o);
    return v;
}
template <bool H>
__device__ __forceinline__ void transpose_item(const float* __restrict__ W, int ldw, int col0, int k0, bf16* __restrict__ WT, int K, int n0, LAS float* scr, int lane) {
#pragma unroll 8
    for (int i = 0; i < 32; ++i) { const int kk = 2 * i + (lane >> 5); scr[kk * 33 + (lane & 31)] = W[(size_t)(k0 + kk) * ldw + col0 + (lane & 31)]; }
    asm volatile("s_waitcnt lgkmcnt(0)" ::: "memory");
    const int c = lane & 7;
#pragma unroll
    for (int j = 0; j < 4; ++j) { const int n = (lane >> 3) + 8 * j; const LAS float* s = scr + (8 * c) * 33 + n;
        v4u o; o.x = pk16<H>(s[0 * 33], s[1 * 33]); o.y = pk16<H>(s[2 * 33], s[3 * 33]); o.z = pk16<H>(s[4 * 33], s[5 * 33]); o.w = pk16<H>(s[6 * 33], s[7 * 33]);
        *(v4u*)(WT + (size_t)(n0 + n) * K + k0 + 8 * c) = o; }
    asm volatile("s_waitcnt lgkmcnt(0)" ::: "memory");
}

typedef const __attribute__((address_space(4))) Args* CArgsP;
__device__ __forceinline__ void prologue(CArgsP ap_, LAS unsigned char* lds, int gw, int ngw, int wave, int lane) {
    Args a;
#pragma unroll
    for (int i = 0; i < 15; ++i) a.in[i] = ap_->in[i];
    a.out = ap_->out; a.ws = ap_->ws; a.ph_lo = 0; a.ph_hi = 0;
    unsigned char* ws = a.ws;
    LAS float* scr = (LAS float*)(lds + wave * 16384);
    constexpr int I_P = 16 * 40, I_V = 16 * 8, I_O = 16 * 32, I_GU = 16 * 176, I_D = 44 * 32, I_LAYER = I_P + I_V + I_O + I_GU + I_D;
    for (int it = gw; it < I_LAYER * DEPTH; it += ngw) {
        const int l = it / I_LAYER; int r = it % I_LAYER;
        bf16* wl = (bf16*)(ws + WS_W) + (size_t)l * W_LAYER;
        const float* w_in = a.in[3] + (size_t)l * DM * DIN;
        if (r < I_P) { const int kb = r / 40, nb = r % 40, tile = nb >> 3, r8 = nb & 7, bj = r8 >> 2, wc = r8 & 3; int col;
            if (tile < 2) col = (4 * tile + wc) * 64 + 32 * bj;
            else if (tile < 4) col = 768 + (4 * (tile - 2) + wc) * 64 + 32 * bj;
            else if (wc < 2) col = 512 + wc * 64 + 32 * bj;
            else col = 1280 + (wc - 2) * 64 + 32 * bj;
            transpose_item<true>(w_in, DIN, col, kb * 64, wl + W_P, DM, nb * 32, scr, lane); continue; }
        r -= I_P;
        if (r < I_V) { const int kb = r / 8, nb = r % 8; const int col = nb < 4 ? 640 + 32 * nb : 1408 + 32 * (nb - 4);
            transpose_item<true>(w_in, DIN, col, kb * 64, wl + W_V, DM, nb * 32, scr, lane); continue; }
        r -= I_V;
        if (r < I_O) { const int kb = r / 32, nb = r % 32;
            transpose_item<false>(a.in[4] + (size_t)l * DM * DM, DM, nb * 32, kb * 64, wl + W_O, DM, nb * 32, scr, lane); continue; }
        r -= I_O;
        if (r < I_GU) { const int kb = r / 176, nb = r % 176, pn = nb >> 3, r8 = nb & 7;
            const float* src = (r8 < 4 ? a.in[10] : a.in[11]) + (size_t)l * DM * DFF;
            transpose_item<true>(src, DFF, 128 * pn + 32 * (r8 & 3), kb * 64, wl + W_GU, DM, nb * 32, scr, lane); continue; }
        r -= I_GU;
        { const int kb = r / 32, nb = r % 32;
            transpose_item<false>(a.in[12] + (size_t)l * DFF * DM, DM, nb * 32, kb * 64, wl + W_D, DFF, nb * 32, scr, lane); }
    }
    bf16* XB = (bf16*)(ws + WS_XB);
    for (int row = gw; row < MTOT; row += ngw) {
        const float* src = row < MHALF ? a.in[0] + (size_t)row * DM : a.in[1] + (size_t)(row - MHALF) * DM;
        const f32x4* xr = (const f32x4*)src + lane; v2u* ob = (v2u*)(XB + (size_t)row * DM) + lane;
#pragma unroll
        for (int j = 0; j < 4; ++j) { const f32x4 v = xr[64 * j]; v2u w; w.x = pkh(v[0], v[1]); w.y = pkh(v[2], v[3]); ob[64 * j] = w; }
    }
    const int gt = gw * 64 + lane, ngt = ngw * 64;
    float* rope = (float*)(ws + WS_ROPE);
    for (int i = gt; i < 128 * 16; i += ngt) { const int pos = i >> 4, j = i & 15;
        const float inv = powf(10000.0f, -(float)(2 * j) / 32.0f); const float ang = (float)pos * inv;
        rope[2 * i] = cosf(ang); rope[2 * i + 1] = sinf(ang); }
    float* lutg = (float*)(ws + WS_LUT);
    for (int i = gt; i < 8 * 452; i += ngt) { const int h = i / 452, idx = i % 452; float v = -1e30f; const int rel = idx - 224;
        if (rel >= -128 && rel <= 128) { const int n = rel < 0 ? -rel : rel; int bucket = rel > 0 ? 16 : 0;
            int large = 8 + (n >= 12) + (n >= 16) + (n >= 23) + (n >= 32) + (n >= 46) + (n >= 64) + (n >= 91); large = large > 15 ? 15 : large;
            bucket += n < 8 ? n : large; v = a.in[2][bucket * 8 + h] * LOG2E_F; }
        lutg[i] = v; }
}

__device__ __forceinline__ f32x4 bf4(v2u m) { f32x4 f; f[0] = __builtin_bit_cast(float, m.x << 16); f[1] = __builtin_bit_cast(float, m.x & 0xffff0000u); f[2] = __builtin_bit_cast(float, m.y << 16); f[3] = __builtin_bit_cast(float, m.y & 0xffff0000u); return f; }
__device__ __forceinline__ f32x4 h4(v2u m) { const h16x4 h = __builtin_bit_cast(h16x4, m); return __builtin_convertvector(h, f32x4); }
template <bool FINAL>
__device__ __forceinline__ void ln_phase(float* OUT, const bf16* MXlo, const bf16* MXhi, bf16* XB, const float* __restrict__ g, const float* __restrict__ b, int gw, int ngw, int lane) {
    constexpr int R = 4;
    for (int row0 = gw; row0 < MTOT; row0 += R * ngw) {
        f32x4 v[R][4];
#pragma unroll
        for (int r = 0; r < R; ++r) { const int row = row0 + r * ngw; if (row < MTOT) {
            const v2u* xr = (const v2u*)(XB + (size_t)row * DM) + lane; const v2u* mr = (const v2u*)((row < MHALF ? MXlo : MXhi) + (size_t)row * DM) + lane;
#pragma unroll
            for (int j = 0; j < 4; ++j) v[r][j] = h4(xr[64 * j]) * ALPHA_DN + bf4(mr[64 * j]); } }
#pragma unroll
        for (int r = 0; r < R; ++r) { const int row = row0 + r * ngw; if (row < MTOT) {
            f32x4* orow = (f32x4*)(OUT + (size_t)row * DM) + lane; v2u* ob = (v2u*)(XB + (size_t)row * DM) + lane;
            float s = 0.f;
#pragma unroll
            for (int j = 0; j < 4; ++j) s += (v[r][j][0] + v[r][j][1]) + (v[r][j][2] + v[r][j][3]);
            const float mean = wave_sum(s) * (1.f / DM); float s2 = 0.f;
#pragma unroll
            for (int j = 0; j < 4; ++j) { v[r][j] = v[r][j] - mean; s2 += (v[r][j][0] * v[r][j][0] + v[r][j][1] * v[r][j][1]) + (v[r][j][2] * v[r][j][2] + v[r][j][3] * v[r][j][3]); }
            const float rstd = 1.f / sqrtf(wave_sum(s2) * (1.f / DM) + 1e-5f);
#pragma unroll
            for (int j = 0; j < 4; ++j) { const f32x4 y = v[r][j] * rstd * ((const f32x4*)g)[lane + 64 * j] + ((const f32x4*)b)[lane + 64 * j];
                if (FINAL) orow[64 * j] = y; else { v2u w; w.x = pkh(y[0], y[1]); w.y = pkh(y[2], y[3]); ob[64 * j] = w; } } } }
    }
}

typedef const __attribute__((address_space(4))) Args* CArgs;
__device__ __forceinline__ CArgs argp() { CArgs p = (CArgs)__builtin_amdgcn_kernarg_segment_ptr(); asm volatile("" : "+s"(p)); return p; }
struct Ids { int lane, wave, G, bx, vcu, gw, ngw; };
__device__ __forceinline__ Ids ids0() { Ids r; int tid_ = threadIdx.x; asm volatile("" : "+v"(tid_)); r.lane = tid_ & 63; r.wave = __builtin_amdgcn_readfirstlane(tid_ >> 6);
    int g_ = gridDim.x, b_ = blockIdx.x; asm volatile("" : "+s"(g_), "+s"(b_)); r.G = g_; r.bx = b_; r.vcu = b_; r.gw = r.vcu * NWAVES + r.wave; r.ngw = g_ * NWAVES; return r; }
__device__ __forceinline__ Ids ids(volatile LAS unsigned* st) { Ids r; int tid_ = threadIdx.x; asm volatile("" : "+v"(tid_)); r.lane = tid_ & 63; r.wave = __builtin_amdgcn_readfirstlane(tid_ >> 6);
    int g_ = gridDim.x; asm volatile("" : "+s"(g_)); r.G = g_; r.vcu = __builtin_amdgcn_readfirstlane((int)st[4]); r.bx = __builtin_amdgcn_readfirstlane((int)st[5]); r.gw = r.vcu * NWAVES + r.wave; r.ngw = g_ * NWAVES; return r; }

__device__ __forceinline__ void place_workgroup(volatile LAS unsigned* st, unsigned* bar_) {
    if (threadIdx.x == 0) { const unsigned x_ = st[2], rank_ = st[3], per_ = gridDim.x / 8u; unsigned pre_ = 0u, xi_ = 0u, nx_ = 0u; bool eq_ = true;
        for (unsigned j = 0; j < 16u; ++j) { const unsigned c_ = xb_ld(&bar_[XB_XCNT(j)]); if (c_) { ++nx_; eq_ = eq_ && (c_ == per_); } if (j < x_) { pre_ += c_; xi_ += c_ ? 1u : 0u; } }
        const unsigned v_ = pre_ + rank_; st[4] = v_; st[5] = (eq_ && nx_ == 8u && gridDim.x % 8u == 0u) ? rank_ * 8u + xi_ : v_; }
    __syncthreads();
}
__global__ void __launch_bounds__(NWAVES * 64, 2) mega_fwd(Args a_unused) {
    extern __shared__ __attribute__((aligned(16))) unsigned char lds_raw[];
    LAS unsigned char* lds = (LAS unsigned char*)lds_raw;
    cg::grid_group grid = cg::this_grid();
    volatile LAS unsigned* bst = (volatile LAS unsigned*)(lds + 131072);
    if (threadIdx.x < 8) bst[threadIdx.x] = 0u;
    __syncthreads();
    if (threadIdx.x == 0) { unsigned* bar_ = (unsigned*)(argp()->ws + WS_BAR); const unsigned x_ = xb_xcc_id(); bst[2] = x_; bst[3] = xb_add(&bar_[XB_XCNT(x_)], 1u); }
    const int ph_lo = argp()->ph_lo, ph_hi = argp()->ph_hi;
    int ph = 0;
#define PH_ON (ph >= ph_lo && ph < ph_hi)
#define PH_END do { if (ph >= ph_lo && ph + 1 < ph_hi) { if (ph == 0) { grid.sync(); place_workgroup(bst, (unsigned*)(argp()->ws + WS_BAR)); } else { XcdBarrier xb_; xb_.bar = (unsigned*)(argp()->ws + WS_BAR); xb_.x = xb_xcc_id(); xb_.st = bst; xcd_barrier(xb_); } } ++ph; } while (0)

    if (PH_ON) {
#pragma unroll 1
        for (int rep_ = 0; rep_ < DUP_PRO; ++rep_) { const Ids I = ids0(); prologue(argp(), lds, I.gw, I.ngw, I.wave, I.lane); } }
    PH_END;
#pragma unroll 1
    for (int l = 0; l < DEPTH; ++l) {
        if (PH_ON) {
#pragma unroll 1
            for (int rep_ = 0; rep_ < DUP_P1; ++rep_) {
            const Ids I = ids(bst); CArgs ap = argp(); unsigned char* ws = ap->ws;
            const bf16* wl = (const bf16*)(ws + WS_W) + (size_t)l * W_LAYER; bf16* XB = (bf16*)(ws + WS_XB);
            { const f32x4* rsrc = (const f32x4*)(ws + WS_ROPE); LAS f32x4* rdst = (LAS f32x4*)(lds + LDS_ROPE);
              for (int i = threadIdx.x; i < 1024; i += NWAVES * 64) rdst[i] = rsrc[i];
              __syncthreads(); }
            { pg8::Gemm g{XB, wl + W_P, MTOT, NPROJ, DM}; pg8::StaticOrder S; S.init(MTOT, NPROJ, I.G, I.bx);
              pg8::EpiProj E{(bf16*)(ws + WS_PROJ), ap->in[6] + l * 64, ap->in[7] + l * 64, (const LAS float*)(lds + LDS_ROPE)};
              pg8::gemm_phase<pg8::EpiProj, pg8::StaticOrder, true, true, true>(lds, g, S, E); }
            { pg8::Gemm g{wl + W_V, XB, 256, MTOT, DM}; pg8::StaticOrder S; S.init(256, MTOT, I.G, I.bx);
              pg8::EpiVT E{(bf16*)(ws + WS_VT)};
              pg8::gemm_phase<pg8::EpiVT, pg8::StaticOrder, true, true, true>(lds, g, S, E); }
            }
        }
        PH_END;
        if (PH_ON) {
            const Ids I = ids(bst); CArgs ap = argp(); unsigned char* ws = ap->ws;
            const bf16* PROJ = (const bf16*)(ws + WS_PROJ); const bf16* VT = (const bf16*)(ws + WS_VT); bf16* AO = (bf16*)ap->out;   const float* lutg = (const float*)(ws + WS_LUT);
            const float* sinkp = ap->in[5] + l * 8;
            float gq = fabsf(ap->in[6][l * 64 + I.lane]), gk = fabsf(ap->in[7][l * 64 + I.lane]);
#pragma unroll
            for (int o_ = 1; o_ < 64; o_ <<= 1) { gq = fmaxf(gq, __shfl_xor(gq, o_)); gk = fmaxf(gk, __shfl_xor(gk, o_)); }
            const float bound2 = 64.0f * QSCALE_F * gq * gk * 1.01f;
            if (bound2 <= 100.0f) {
#pragma unroll 1
            for (int rep_ = 0; rep_ < DUP_ATT; ++rep_)
#pragma unroll 1
            for (int u = I.vcu; u < 4096; u += I.G) {
                const int kind = u >> 10, idx = u & 1023; const bool sample = kind & 1, win = kind >= 2;
                const int S = sample ? 8192 : 4096, nqb = S >> 8, per = 4 * nqb;
                const int bk = idx / per, rem = idx % per, b = bk >> 1, kvh = bk & 1, hq = kvh * 4 + rem / nqb, qb = rem % nqb;
                const int rowbase = (sample ? MHALF : 0) + b * S;
                if (win) att::attn_win(lds, PROJ, VT, AO, rowbase, S, kvh, rem * 64, lutg, sinkp);
                else att::attn_global(lds, PROJ, VT, AO, rowbase, S, hq, qb * 256, bound2);
            }
            } else {
#pragma unroll 1
            for (int u = I.vcu; u < 4096; u += I.G) {
                const int kind = u >> 10, idx = u & 1023; const bool sample = kind & 1, win = kind >= 2;
                const int S = sample ? 8192 : 4096, nqb = S >> 8, per = 4 * nqb;
                const int bk = idx / per, rem = idx % per, b = bk >> 1, kvh = bk & 1, hq = kvh * 4 + rem / nqb, qb = rem % nqb;
                const int rowbase = (sample ? MHALF : 0) + b * S;
                if (win) att::attn_win(lds, PROJ, VT, AO, rowbase, S, kvh, rem * 64, lutg, sinkp);
                else att::attn_unit<0>(lds, PROJ, VT, AO, rowbase, S, hq, qb * 256, lutg, bound2);
            }
            }
        }
        PH_END;
        if (PH_ON) {
            const Ids I = ids(bst); CArgs ap = argp(); unsigned char* ws = ap->ws;
            const bf16* wl = (const bf16*)(ws + WS_W) + (size_t)l * W_LAYER;
            pg8::Gemm g{(const bf16*)ap->out, wl + W_O, MTOT, DM, DM}; pg8::StaticOrder S; S.init(MTOT, DM, I.G, I.bx);
            pg8::EpiBf16 E{(bf16*)(ws + WS_PROJ), DM};
#pragma unroll 1
            for (int rep_ = 0; rep_ < DUP_OP; ++rep_)
            pg8::gemm_phase<pg8::EpiBf16, pg8::StaticOrder, true, true>(lds, g, S, E);
        }
        PH_END;
        if (PH_ON) { const Ids I = ids(bst); CArgs ap = argp(); const bf16* mx = (const bf16*)(ap->ws + WS_PROJ);
            ln_phase<false>(ap->out, mx, mx, (bf16*)(ap->ws + WS_XB), ap->in[8] + l * DM, ap->in[9] + l * DM, I.gw, I.ngw, I.lane); }
        PH_END;
#pragma unroll 1
        for (int half = 0; half < 2; ++half) {
            if (PH_ON) {
                const Ids I = ids(bst); CArgs ap = argp(); unsigned char* ws = ap->ws;
                const bf16* wl = (const bf16*)(ws + WS_W) + (size_t)l * W_LAYER;
                pg8::Gemm g{(const bf16*)(ws + WS_XB) + (size_t)half * MHALF * DM, wl + W_GU, MHALF, 2 * DFF, DM}; pg8::StaticOrder S; S.init(MHALF, 2 * DFF, I.G, I.bx);
                pg8::EpiSwiGLU E{(bf16*)(ws + WS_H), DFF};
#pragma unroll 1
                for (int rep_ = 0; rep_ < DUP_FFN1; ++rep_)
                pg8::gemm_phase<pg8::EpiSwiGLU, pg8::StaticOrder, true, true, true>(lds, g, S, E);
            }
            PH_END;
            if (PH_ON) {
                const Ids I = ids(bst); CArgs ap = argp(); unsigned char* ws = ap->ws;
                const bf16* wl = (const bf16*)(ws + WS_W) + (size_t)l * W_LAYER;
                pg8::Gemm g{(const bf16*)(ws + WS_H), wl + W_D, MHALF, DM, DFF}; pg8::StaticOrder S; S.init(MHALF, DM, I.G, I.bx);
                pg8::EpiBf16 E{half == 0 ? (bf16*)(ws + WS_MX0) : (l < DEPTH - 1 ? (bf16*)((char*)ap->out + 128 * MiB) : (bf16*)(ws + WS_W)), DM};
#pragma unroll 1
                for (int rep_ = 0; rep_ < DUP_DN; ++rep_)
                pg8::gemm_phase<pg8::EpiBf16, pg8::StaticOrder, true, true>(lds, g, S, E);
            }
            PH_END;
        }
        if (PH_ON) { const Ids I = ids(bst); CArgs ap = argp(); const bf16* mlo = (const bf16*)(ap->ws + WS_MX0); bf16* xb = (bf16*)(ap->ws + WS_XB);
            const bf16* mhi = (l < DEPTH - 1 ? (const bf16*)((const char*)ap->out + 128 * MiB) : (const bf16*)(ap->ws + WS_W)) - (size_t)MHALF * DM;
            if (l == DEPTH - 1) ln_phase<true>(ap->out, mlo, mhi, xb, ap->in[13] + l * DM, ap->in[14] + l * DM, I.gw, I.ngw, I.lane);
            else ln_phase<false>(ap->out, mlo, mhi, xb, ap->in[13] + l * DM, ap->in[14] + l * DM, I.gw, I.ngw, I.lane); }
        PH_END;
    }
}
constexpr int N_PHASES = 1 + DEPTH * 9;

#ifndef MK_MULTI
#define MK_MULTI 0
#endif
extern "C" void kernel_launch(void* const* d_in, const int* in_sizes, int n_in, void* d_out, int out_size, void* d_ws, size_t ws_size, hipStream_t stream) {
    static int grid = 0;
    if (grid == 0) {
        if (n_in != 15 || out_size != MTOT * DM || ws_size < WS_END) { fprintf(stderr, "kernel_launch: unexpected shapes: n_in %d out %d ws %zu (need %zu)\n", n_in, out_size, ws_size, (size_t)WS_END); grid = -1; return; }
        int dev = 0, cus = 0, per_cu = 0;
        hipGetDevice(&dev); hipDeviceGetAttribute(&cus, hipDeviceAttributeMultiprocessorCount, dev);
        if (hipFuncSetAttribute((const void*)mega_fwd, hipFuncAttributeMaxDynamicSharedMemorySize, LDS_BYTES) != hipSuccess) { fprintf(stderr, "kernel_launch: hipFuncSetAttribute failed\n"); grid = -1; return; }
        if (hipOccupancyMaxActiveBlocksPerMultiprocessor(&per_cu, (const void*)mega_fwd, NWAVES * 64, LDS_BYTES) != hipSuccess || per_cu < 1) { fprintf(stderr, "kernel_launch: occupancy query gave %d\n", per_cu); per_cu = 1; }
        (void)hipGetLastError();
        grid = cus * per_cu;
        fprintf(stderr, "kernel_launch: grid %d (cus %d x %d), ws %zu\n", grid, cus, per_cu, ws_size);
    }
    if (grid < 0) return;
    if (hipMemsetAsync((char*)d_ws + WS_BAR, 0, 16384, stream) != hipSuccess) { fprintf(stderr, "kernel_launch: memset failed\n"); return; }
    Args a{};
    for (int i = 0; i < 15; ++i) a.in[i] = (const float*)d_in[i];
    a.out = (float*)d_out; a.ws = (unsigned char*)d_ws;
#if MK_MULTI
    for (int p = 0; p < N_PHASES; ++p) { a.ph_lo = p; a.ph_hi = p + 1; hipLaunchKernelGGL(mega_fwd, dim3(grid), dim3(NWAVES * 64), LDS_BYTES, stream, a); }
#else
    a.ph_lo = 0; a.ph_hi = N_PHASES;
    void* args[] = {&a};
    hipError_t e = hipLaunchCooperativeKernel((const void*)mega_fwd, dim3(grid), dim3(NWAVES * 64), args, LDS_BYTES, stream);
    if (e != hipSuccess) fprintf(stderr, "cooperative launch failed: %s (grid %d)\n", hipGetErrorString(e), grid);
#endif
}
```
